# Optimizing an MI355X kernel written in HIP

```python
import math
import jax
import jax.numpy as jnp
from jax import lax
import numpy as np

D_MODEL = 2048
BATCH = 1
SEQ = 8192
DEPTH = 2

ATTN_HEAD_DIM = 128
ATTN_WIDTH = D_MODEL // 2
N_ATTN_HEADS = ATTN_WIDTH // ATTN_HEAD_DIM
POOL_WIDTH = D_MODEL // 4
POOL_WINDOWS = (2, 4, 8, 16)
POOL_GROUP = POOL_WIDTH // len(POOL_WINDOWS)
LRU_WIDTH = D_MODEL // 4
N_LRU_BLOCKS = 4
LRU_BLOCK = LRU_WIDTH // N_LRU_BLOCKS
LRU_C = 8.0
CONV_WIDTH = 4
N_IDX_HEADS = 16
IDX_DIM = 64
TOPK_MAX = 256
QUERY_BLOCK = 128
N_BUCKETS = 32
MAX_DISTANCE = 128
MLP_HIDDEN = 4 * D_MODEL
NORM_EPS = 1e-6
COLUMN_SIZES = (ATTN_WIDTH, ATTN_WIDTH, ATTN_WIDTH, N_IDX_HEADS * IDX_DIM, IDX_DIM,
                N_IDX_HEADS, POOL_WIDTH, LRU_WIDTH, LRU_WIDTH)
IN_WIDTH = 3 * ATTN_WIDTH + N_IDX_HEADS * IDX_DIM + IDX_DIM + N_IDX_HEADS + POOL_WIDTH + 2 * LRU_WIDTH

kernel_name = 'hybrid_dsa_pool_rglru_block'


def rms_norm(x, g):
    xf = x.astype(jnp.float32)
    y = xf * lax.rsqrt(jnp.mean(xf * xf, axis=-1, keepdims=True) + NORM_EPS)
    return (y * g.astype(jnp.float32)).astype(x.dtype)


def split_columns(proj):
    out = []
    start = 0
    for size in COLUMN_SIZES:
        out.append(proj[..., start:start + size])
        start += size
    return out


def t5_bucket(rel):
    max_exact = N_BUCKETS // 2
    rel = jnp.maximum(rel, 0)
    relf = jnp.maximum(rel.astype(jnp.float32), 1.0)
    large = max_exact + (jnp.log(relf / max_exact) / math.log(MAX_DISTANCE / max_exact)
                         * (N_BUCKETS - max_exact)).astype(jnp.int32)
    large = jnp.minimum(large, N_BUCKETS - 1)
    return jnp.where(rel < max_exact, rel, large)


def dsa_attention(q, k, v, q_idx, k_idx, w_idx, positions, rel_bias):
    B, L = q.shape[0], q.shape[1]
    top_k = min(TOPK_MAX, L // 4)
    qb = min(QUERY_BLOCK, L)
    n_blocks = L // qb
    scale = ATTN_HEAD_DIM ** -0.5
    idx_scale = (N_IDX_HEADS * IDX_DIM) ** -0.5
    k_idx_f = k_idx.astype(jnp.float32)
    gather = jax.vmap(lambda arr, ids: arr[ids])

    def block(start):
        qs = lax.dynamic_slice_in_dim(q, start, qb, axis=1)
        qi = lax.dynamic_slice_in_dim(q_idx, start, qb, axis=1)
        wi = lax.dynamic_slice_in_dim(w_idx, start, qb, axis=1)
        pq = lax.dynamic_slice_in_dim(positions, start, qb, axis=1)
        dots = jnp.einsum('bqhd,bsd->bqhs', qi.astype(jnp.float32), k_idx_f)
        score = jnp.einsum('bqh,bqhs->bqs', wi.astype(jnp.float32), jax.nn.relu(dots)) * idx_scale
        admissible = positions[:, None, :] <= pq[:, :, None]
        score = jnp.where(admissible, score, -jnp.inf)
        _, sel = lax.top_k(score, top_k)
        valid = jnp.take_along_axis(admissible, sel, axis=-1)
        k_sel = gather(k, sel)
        v_sel = gather(v, sel)
        pos_sel = gather(positions, sel)
        bias = rel_bias[t5_bucket(pq[:, :, None] - pos_sel)]
        logits = (jnp.einsum('bqhd,bqkhd->bhqk', qs, k_sel).astype(jnp.float32) * scale
                  + jnp.transpose(bias.astype(jnp.float32), (0, 3, 1, 2)))
        logits = jnp.where(valid[:, None, :, :], logits, -jnp.inf)
        p = jax.nn.softmax(logits, axis=-1).astype(v.dtype)
        out = jnp.einsum('bhqk,bqkhd->bqhd', p, v_sel)
        return out.reshape(B, qb, -1)

    outs = lax.map(block, jnp.arange(n_blocks, dtype=jnp.int32) * qb)
    return jnp.transpose(outs, (1, 0, 2, 3)).reshape(B, L, -1)


def pool_mixer(u, pool_w, pool_scale):
    B, L, C = u.shape
    uf = u.astype(jnp.float32)
    cs = jnp.concatenate([jnp.zeros((B, 1, C), jnp.float32), jnp.cumsum(uf, axis=1)], axis=1)
    t = jnp.arange(L)
    diffs = []
    for g, win in enumerate(POOL_WINDOWS):
        sl = slice(g * POOL_GROUP, (g + 1) * POOL_GROUP)
        csg = cs[:, :, sl]
        lo = jnp.maximum(t + 1 - win, 0)
        count = jnp.minimum(t + 1, win).astype(jnp.float32)
        diffs.append((csg[:, 1:] - csg[:, lo]) / count[None, :, None] - uf[:, :, sl])
    d = jnp.stack(diffs, axis=2)
    y = jnp.einsum('blgc,gcd->blgd', d, pool_w.astype(jnp.float32)).reshape(B, L, C)
    return (y * pool_scale.astype(jnp.float32)).astype(u.dtype)


def rglru_mixer(u, gate, conv_w, conv_b, r_w, r_b, i_w, i_b, lam):
    B, L, C = u.shape
    xc = lax.conv_general_dilated(u, conv_w[:, None, :], window_strides=(1,),
                                  padding=[(CONV_WIDTH - 1, 0)],
                                  dimension_numbers=('NWC', 'WIO', 'NWC'),
                                  feature_group_count=C) + conv_b
    xb = xc.reshape(B, L, N_LRU_BLOCKS, LRU_BLOCK)
    r = jax.nn.sigmoid(jnp.einsum('blgc,gcd->blgd', xb, r_w).reshape(B, L, C) + r_b)
    i = jax.nn.sigmoid(jnp.einsum('blgc,gcd->blgd', xb, i_w).reshape(B, L, C) + i_b)
    log_a = -LRU_C * r.astype(jnp.float32) * jax.nn.softplus(-lam.astype(jnp.float32))
    a = jnp.exp(log_a)
    b = jnp.sqrt(-jnp.expm1(2.0 * log_a)) * (i * xc).astype(jnp.float32)

    def combine(left, right):
        a1, b1 = left
        a2, b2 = right
        return a1 * a2, a2 * b1 + b2

    _, h = lax.associative_scan(combine, (a, b), axis=1)
    return (h * jax.nn.gelu(gate.astype(jnp.float32))).astype(u.dtype)


def setup_inputs(seed: int = 0) -> dict:
    key = jax.random.key(seed)
    ks = jax.random.split(key, 28)
    f32 = jnp.float32
    D = D_MODEL

    def nrm(k, shape, s):
        return jax.random.normal(k, shape, f32) * s

    def gain(k, n):
        return 1.0 + nrm(k, (DEPTH, n), 0.05)

    x = nrm(ks[0], (BATCH, SEQ, D), 1.0)
    c = nrm(ks[1], (BATCH, D), 1.0)
    offset = jax.random.randint(ks[2], (BATCH, 1), 0, 4096, dtype=jnp.int32)
    positions = offset + jnp.arange(SEQ, dtype=jnp.int32)[None, :]
    rel_bias = nrm(ks[3], (N_BUCKETS, N_ATTN_HEADS), 0.5)
    w_mod = nrm(ks[4], (DEPTH, D, 6 * D), 0.5 * D ** -0.5)
    b_mod = nrm(ks[5], (DEPTH, 6 * D), 0.01)
    g_pre_mix = gain(ks[6], D)
    g_post_mix = gain(ks[7], D)
    g_pre_mlp = gain(ks[8], D)
    g_post_mlp = gain(ks[9], D)
    w_in = nrm(ks[10], (DEPTH, D, IN_WIDTH), D ** -0.5)
    pool_w = nrm(ks[11], (DEPTH, len(POOL_WINDOWS), POOL_GROUP, POOL_GROUP), POOL_GROUP ** -0.5)
    pool_scale = 1.0 + nrm(ks[12], (DEPTH, POOL_WIDTH), 0.1)
    conv_w = nrm(ks[13], (DEPTH, CONV_WIDTH, LRU_WIDTH), CONV_WIDTH ** -0.5)
    conv_b = nrm(ks[14], (DEPTH, LRU_WIDTH), 0.01)
    gate_r_w = nrm(ks[15], (DEPTH, N_LRU_BLOCKS, LRU_BLOCK, LRU_BLOCK), LRU_BLOCK ** -0.5)
    gate_r_b = nrm(ks[16], (DEPTH, LRU_WIDTH), 0.1)
    gate_i_w = nrm(ks[17], (DEPTH, N_LRU_BLOCKS, LRU_BLOCK, LRU_BLOCK), LRU_BLOCK ** -0.5)
    gate_i_b = nrm(ks[18], (DEPTH, LRU_WIDTH), 0.1)
    a_c = jax.random.uniform(ks[19], (DEPTH, LRU_WIDTH), f32, 0.9, 0.999)
    s = a_c ** (1.0 / LRU_C)
    lru_lambda = jnp.log(s) - jnp.log1p(-s)
    g_attn_out = gain(ks[20], ATTN_WIDTH)
    g_pool_out = gain(ks[21], POOL_WIDTH)
    g_lru_out = gain(ks[22], LRU_WIDTH)
    w_out = nrm(ks[23], (DEPTH, D, D), D ** -0.5)
    w_mlp_up = nrm(ks[24], (DEPTH, D, MLP_HIDDEN), D ** -0.5)
    w_mlp_down = nrm(ks[25], (DEPTH, MLP_HIDDEN, D), MLP_HIDDEN ** -0.5)
    return {'x': x, 'c': c, 'positions': positions, 'rel_bias': rel_bias,
            'w_mod': w_mod, 'b_mod': b_mod,
            'g_pre_mix': g_pre_mix, 'g_post_mix': g_post_mix,
            'g_pre_mlp': g_pre_mlp, 'g_post_mlp': g_post_mlp,
            'w_in': w_in, 'pool_w': pool_w, 'pool_scale': pool_scale,
            'conv_w': conv_w, 'conv_b': conv_b,
            'gate_r_w': gate_r_w, 'gate_r_b': gate_r_b,
            'gate_i_w': gate_i_w, 'gate_i_b': gate_i_b, 'lru_lambda': lru_lambda,
            'g_attn_out': g_attn_out, 'g_pool_out': g_pool_out, 'g_lru_out': g_lru_out,
            'w_out': w_out, 'w_mlp_up': w_mlp_up, 'w_mlp_down': w_mlp_down}


def reference(x, c, positions, rel_bias, w_mod, b_mod, g_pre_mix, g_post_mix, g_pre_mlp,
              g_post_mlp, w_in, pool_w, pool_scale, conv_w, conv_b, gate_r_w, gate_r_b,
              gate_i_w, gate_i_b, lru_lambda, g_attn_out, g_pool_out, g_lru_out, w_out,
              w_mlp_up, w_mlp_down):
    B, L, _ = x.shape
    c_act = jax.nn.silu(c)
    for l in range(DEPTH):
        mod = c_act @ w_mod[l] + b_mod[l]
        shift1, scale1, gate1, shift2, scale2, gate2 = [m[:, None, :] for m in jnp.split(mod, 6, axis=-1)]

        h = rms_norm(x, g_pre_mix[l]) * (1.0 + scale1) + shift1
        proj = h @ w_in[l]
        q, k, v, q_idx, k_idx, w_idx, pool_in, lru_in, lru_gate = split_columns(proj)
        attn = dsa_attention(q.reshape(B, L, N_ATTN_HEADS, ATTN_HEAD_DIM),
                             k.reshape(B, L, N_ATTN_HEADS, ATTN_HEAD_DIM),
                             v.reshape(B, L, N_ATTN_HEADS, ATTN_HEAD_DIM),
                             q_idx.reshape(B, L, N_IDX_HEADS, IDX_DIM), k_idx, w_idx,
                             positions, rel_bias)
        pool = pool_mixer(pool_in, pool_w[l], pool_scale[l])
        lru = rglru_mixer(lru_in, lru_gate, conv_w[l], conv_b[l], gate_r_w[l], gate_r_b[l],
                          gate_i_w[l], gate_i_b[l], lru_lambda[l])
        mixed = jnp.concatenate([rms_norm(attn, g_attn_out[l]),
                                 rms_norm(pool, g_pool_out[l]),
                                 rms_norm(lru, g_lru_out[l])], axis=-1)
        y = mixed @ w_out[l]
        x = x + gate1 * rms_norm(y, g_post_mix[l])

        h = rms_norm(x, g_pre_mlp[l]) * (1.0 + scale2) + shift2
        u = jax.nn.relu(h @ w_mlp_up[l])
        y = (u * u) @ w_mlp_down[l]
        x = x + gate2 * rms_norm(y, g_post_mlp[l])
    return x
```

```cpp
#include <hip/hip_runtime.h>
#include <stdint.h>

namespace {
typedef _Float16 f16;
typedef _Float16 f16x8 __attribute__((ext_vector_type(8)));
typedef _Float16 f16x4 __attribute__((ext_vector_type(4)));
typedef _Float16 f16x2 __attribute__((ext_vector_type(2)));
typedef float f32x4 __attribute__((ext_vector_type(4)));
typedef float f32x16 __attribute__((ext_vector_type(16)));
typedef unsigned u32x4 __attribute__((ext_vector_type(4)));
typedef unsigned u32x2 __attribute__((ext_vector_type(2)));
#define LAS __attribute__((address_space(3)))

constexpr int D = 2048, L = 8192, DEPTH = 2;
constexpr int AW = 1024, NH = 8, HD = 128;
constexpr int PW = 512;
constexpr int LW = 512;
constexpr int NIH = 16, IDIM = 64;
constexpr int TOPK = 256;
constexpr int MLPH = 8192;
constexpr int INW = 5712;
constexpr int INP = 5888;
constexpr float EPS = 1e-6f;
constexpr int NBLK = 256, NTHR = 512;

__device__ __forceinline__ int phase_tid(int w0) { int t; asm volatile("v_mbcnt_lo_u32_b32 %0, -1, 0\n\tv_mbcnt_hi_u32_b32 %0, -1, %0\n\tv_lshl_or_b32 %0, %1, 6, %0" : "=&v"(t) : "s"(w0)); t &= 511; return t; }
template <int O> __device__ __forceinline__ float swz_xor(float v) { return __int_as_float(__builtin_amdgcn_ds_swizzle(__float_as_int(v), (O << 10) | 0x1F)); }
__device__ __forceinline__ float half_sum(float v) { auto r = __builtin_amdgcn_permlane32_swap(__float_as_uint(v), __float_as_uint(v), false, false); return __uint_as_float(r[0]) + __uint_as_float(r[1]); }
__device__ __forceinline__ int wave_sum_i(int v) {
    v += __builtin_amdgcn_ds_swizzle(v, (1 << 10) | 0x1F); v += __builtin_amdgcn_ds_swizzle(v, (2 << 10) | 0x1F); v += __builtin_amdgcn_ds_swizzle(v, (4 << 10) | 0x1F);
    v += __builtin_amdgcn_ds_swizzle(v, (8 << 10) | 0x1F); v += __builtin_amdgcn_ds_swizzle(v, (16 << 10) | 0x1F);
    auto r = __builtin_amdgcn_permlane32_swap((unsigned)v, (unsigned)v, false, false); return (int)(r[0] + r[1]);
}
__device__ __forceinline__ float wave_sum(float v) {
    v += swz_xor<1>(v); v += swz_xor<2>(v); v += swz_xor<4>(v); v += swz_xor<8>(v); v += swz_xor<16>(v);
    return half_sum(v);
}
__device__ __forceinline__ unsigned pack2(float a, float b) { f16x2 h = {(f16)a, (f16)b}; return *reinterpret_cast<unsigned*>(&h); }
template <bool WIN>
__device__ __forceinline__ void conv_tile(const float* __restrict__ src, int Nsrc, int K, f16* __restrict__ dst, int kt, int nt, LAS float* tile  , int w0) {
    const int tid = phase_tid(w0), k0 = kt * 64, n0 = nt * 128;
#pragma unroll
    for (int i = 0; i < 4; ++i) {
        const int idx = tid + 512 * i, row = idx >> 5, c4 = (idx & 31) * 4, np = n0 + c4;
        int col = np; bool z = false;
        if (WIN) { if (np >= 4352) col = np - 176; else if (np >= 4176) z = true; }
        f32x4 v = {0.f, 0.f, 0.f, 0.f};
        if (!z) v = *(const f32x4*)(src + (size_t)(k0 + row) * Nsrc + col);
        LAS float* tp = tile + row * 129 + c4;
        tp[0] = v[0]; tp[1] = v[1]; tp[2] = v[2]; tp[3] = v[3];
    }
    __syncthreads();
    {
        const int n = tid >> 2, kc = tid & 3;
        unsigned w[8];
#pragma unroll
        for (int i = 0; i < 8; ++i) w[i] = pack2(tile[(kc * 16 + 2 * i) * 129 + n], tile[(kc * 16 + 2 * i + 1) * 129 + n]);
        f16* dp = dst + (size_t)(n0 + n) * K + k0 + kc * 16;
        *(u32x4*)dp = (u32x4){w[0], w[1], w[2], w[3]};
        *(u32x4*)(dp + 8) = (u32x4){w[4], w[5], w[6], w[7]};
    }
    __syncthreads();
}

__device__ __forceinline__ void conv_tile_f8(const float* __restrict__ src, int Nsrc, int K, unsigned char* __restrict__ dst, int kt, int nt, float mul, LAS float* tile  , int w0) {
    const int tid = phase_tid(w0), k0 = kt * 64, n0 = nt * 128;
#pragma unroll
    for (int i = 0; i < 4; ++i) {
        const int idx = tid + 512 * i, row = idx >> 5, c4 = (idx & 31) * 4;
        const f32x4 v = *(const f32x4*)(src + (size_t)(k0 + row) * Nsrc + n0 + c4);
        LAS float* tp = tile + row * 129 + c4;
        tp[0] = v[0] * mul; tp[1] = v[1] * mul; tp[2] = v[2] * mul; tp[3] = v[3] * mul;
    }
    __syncthreads();
    {
        const int n = tid >> 2, kc = tid & 3;
        unsigned w[4];
#pragma unroll
        for (int i = 0; i < 4; ++i) { unsigned x = 0u;
            x = __builtin_amdgcn_cvt_pk_fp8_f32(tile[(kc * 16 + 4 * i) * 129 + n], tile[(kc * 16 + 4 * i + 1) * 129 + n], x, false);
            x = __builtin_amdgcn_cvt_pk_fp8_f32(tile[(kc * 16 + 4 * i + 2) * 129 + n], tile[(kc * 16 + 4 * i + 3) * 129 + n], x, true); w[i] = x; }
        *(u32x4*)(dst + (size_t)(n0 + n) * K + k0 + kc * 16) = (u32x4){w[0], w[1], w[2], w[3]};
    }
    __syncthreads();
}

__device__ __forceinline__ void mod_unit(const float* __restrict__ c, const float* __restrict__ w_mod, const float* __restrict__ b_mod, float* __restrict__ mod, int unit, LAS float* lds, int w0) {
    LAS float* sc = lds;
    LAS float* red = lds + 2048;
    const int tid = phase_tid(w0);
    for (int i = tid; i < D; i += NTHR) { const float v = c[i]; sc[i] = v / (1.0f + __expf(-v)); }
    __syncthreads();
    const int n0 = unit * 256, l = n0 / (6 * D), j0 = n0 % (6 * D), kq = tid >> 6, nl = tid & 63;
    const float* w = w_mod + (size_t)l * D * 6 * D + j0 + nl * 4;
    f32x4 acc = {0.f, 0.f, 0.f, 0.f};
#pragma unroll 8
    for (int k = kq; k < D; k += 8) { const f32x4 v = __builtin_nontemporal_load((const f32x4*)(w + (size_t)k * 6 * D)); acc += v * sc[k]; }
    red[kq * 256 + nl * 4 + 0] = acc[0]; red[kq * 256 + nl * 4 + 1] = acc[1]; red[kq * 256 + nl * 4 + 2] = acc[2]; red[kq * 256 + nl * 4 + 3] = acc[3];
    __syncthreads();
    if (tid < 256) { float s = 0.f;
#pragma unroll
        for (int q = 0; q < 8; ++q) s += red[q * 256 + tid];
        mod[n0 + tid] = s + b_mod[n0 + tid]; }
    __syncthreads();
}

struct ProParams { const float* c; const float* w_mod; const float* b_mod; float* mod; const float* w_in; const float* w_out; const float* w_up; const float* w_down;
                   f16* wt_in; f16* wt_out; f16* wt_up; f16* wt_down; const float* pool_w; const float* r_w; const float* i_w; f16* poolWt; f16* rWt; f16* iWt; };
constexpr int CT_IN = 32 * 46, CT_OUT = 32 * 16, CT_UP = 32 * 64, CT_DOWN = 128 * 16, CT_SM = 24, CT_LAYER = CT_IN + CT_OUT + CT_UP + CT_DOWN + CT_SM, CT_TOTAL = DEPTH * CT_LAYER;
struct CTile { const float* src; unsigned char* dst; int Nsrc, K, k0, n0, mode; float mul; };
#define CT_DESC(c, t_) do { const int l = (t_) / CT_LAYER; int r = (t_) % CT_LAYER; const bool last = (l == DEPTH - 1); (c).mul = 1.f; (c).mode = 0;                       \
    if (r < CT_IN) { (c).src = q_w_in + (size_t)l * D * INW; (c).dst = (unsigned char*)(q_wt_in + (size_t)l * INP * D); (c).Nsrc = INW; (c).K = D; (c).k0 = (r % 32) * 64; (c).n0 = (r / 32) * 128; (c).mode = 1; } \
    else if (r < CT_IN + CT_OUT) { r -= CT_IN; (c).src = q_w_out + (size_t)l * D * D; (c).dst = (unsigned char*)(q_wt_out + (size_t)l * D * D); (c).Nsrc = D; (c).K = D; (c).k0 = (r % 32) * 64; (c).n0 = (r / 32) * 128; \
                      if (last) { (c).mode = 2; (c).mul = 64.0f; } }                                              \
    else if (r < CT_IN + CT_OUT + CT_UP) { r -= CT_IN + CT_OUT; (c).src = q_w_up + (size_t)l * D * MLPH; (c).dst = (unsigned char*)(q_wt_up + (size_t)l * MLPH * D); (c).Nsrc = MLPH; (c).K = D; (c).k0 = (r % 32) * 64; (c).n0 = (r / 32) * 128; \
                     (c).mode = 2; (c).mul = 64.0f; }                                                          \
    else if (r < CT_IN + CT_OUT + CT_UP + CT_DOWN) { r -= CT_IN + CT_OUT + CT_UP; (c).src = q_w_down + (size_t)l * MLPH * D; (c).dst = (unsigned char*)(q_wt_down + (size_t)l * D * MLPH); (c).Nsrc = D; (c).K = MLPH; (c).k0 = (r % 128) * 64; (c).n0 = (r / 128) * 128; \
                       (c).mode = 2; (c).mul = 128.0f; }                                                        \
    else { r -= CT_IN + CT_OUT + CT_UP + CT_DOWN; const int mat = r >> 1, kt = r & 1, which = mat >> 2, g = mat & 3; const size_t o = (size_t)(l * 4 + g) * 128 * 128;       \
      if (which == 0) { (c).src = q_pool_w + o; (c).dst = (unsigned char*)(q_poolWt + o); } else if (which == 1) { (c).src = q_r_w + o; (c).dst = (unsigned char*)(q_rWt + o); }   \
      else { (c).src = q_i_w + o; (c).dst = (unsigned char*)(q_iWt + o); }                                                                                                          \
      (c).Nsrc = 128; (c).K = 128; (c).k0 = kt * 64; (c).n0 = 0; } } while (0)
__device__ __forceinline__ void ct_load(const CTile& c, int tid, f32x4 (&v)[4]) {
#pragma unroll
    for (int i = 0; i < 4; ++i) {
        const int idx = tid + 512 * i, row = idx >> 5, c4 = (idx & 31) * 4, np = c.n0 + c4;
        int col = np; bool z = false;
        if (c.mode == 1) {
            if (np < 1024) col = 3072 + np; else if (np < 1104) col = 4096 + (np - 1024); else if (np < 1280) { z = true; col = 0; } else if (np < 2816) col = 4176 + (np - 1280); else col = np - 2816; }
        const f32x4 ld = __builtin_nontemporal_load((const f32x4*)(c.src + (size_t)(c.k0 + row) * c.Nsrc + col));
        v[i] = z ? f32x4{0.f, 0.f, 0.f, 0.f} : ld;
    }
}
__device__ __forceinline__ void ct_store(const CTile& c, int tid, const f32x4 (&v)[4], LAS float* tile  ) {
#pragma unroll
    for (int i = 0; i < 4; ++i) {
        const int idx = tid + 512 * i, row = idx >> 5, c4 = (idx & 31) * 4;
        LAS float* tp = tile + row * 129 + c4;
        tp[0] = v[i][0] * c.mul; tp[1] = v[i][1] * c.mul; tp[2] = v[i][2] * c.mul; tp[3] = v[i][3] * c.mul;
    }
    __syncthreads();
    const int n = tid >> 2, kc = tid & 3;
    if (c.mode == 2) {
        unsigned w[4];
#pragma unroll
        for (int i = 0; i < 4; ++i) { unsigned x = 0u;
            x = __builtin_amdgcn_cvt_pk_fp8_f32(tile[(kc * 16 + 4 * i) * 129 + n], tile[(kc * 16 + 4 * i + 1) * 129 + n], x, false);
            x = __builtin_amdgcn_cvt_pk_fp8_f32(tile[(kc * 16 + 4 * i + 2) * 129 + n], tile[(kc * 16 + 4 * i + 3) * 129 + n], x, true); w[i] = x; }
        __builtin_nontemporal_store((u32x4){w[0], w[1], w[2], w[3]}, (u32x4*)(c.dst + (size_t)(c.n0 + n) * c.K + c.k0 + kc * 16));
    } else {
        unsigned w[8];
#pragma unroll
        for (int i = 0; i < 8; ++i) w[i] = pack2(tile[(kc * 16 + 2 * i) * 129 + n], tile[(kc * 16 + 2 * i + 1) * 129 + n]);
        f16* dp = (f16*)c.dst + (size_t)(c.n0 + n) * c.K + c.k0 + kc * 16;
        __builtin_nontemporal_store((u32x4){w[0], w[1], w[2], w[3]}, (u32x4*)dp);
        __builtin_nontemporal_store((u32x4){w[4], w[5], w[6], w[7]}, (u32x4*)(dp + 8));
    }
    __syncthreads();
}
__device__ __forceinline__ void prologue_phase(int blk, const ProParams& p, LAS float* lds, int w0) {
    constexpr int NMOD = 96, T1 = (CT_TOTAL - (NBLK - NMOD) * 43) / NBLK, REST = CT_TOTAL - NMOD * T1, NB2 = NBLK - NMOD, Q = REST / NB2, R = REST % NB2;
    int lo, hi;
    if (blk < NMOD) { lo = blk * T1; hi = lo + T1; }
    else { const int b = blk - NMOD; lo = NMOD * T1 + b * Q + (b < R ? b : R); hi = lo + Q + (b < R ? 1 : 0); }
    if (blk < NMOD) mod_unit(p.c, p.w_mod, p.b_mod, p.mod, blk, lds, w0);
    const float* q_w_in = p.w_in; asm volatile("" : "+s"(q_w_in));
    const float* q_w_out = p.w_out; asm volatile("" : "+s"(q_w_out));
    const float* q_w_up = p.w_up; asm volatile("" : "+s"(q_w_up));
    const float* q_w_down = p.w_down; asm volatile("" : "+s"(q_w_down));
    const float* q_pool_w = p.pool_w; asm volatile("" : "+s"(q_pool_w));
    const float* q_r_w = p.r_w; asm volatile("" : "+s"(q_r_w));
    const float* q_i_w = p.i_w; asm volatile("" : "+s"(q_i_w));
    f16* q_wt_in = p.wt_in; asm volatile("" : "+s"(q_wt_in));
    f16* q_wt_out = p.wt_out; asm volatile("" : "+s"(q_wt_out));
    f16* q_wt_up = p.wt_up; asm volatile("" : "+s"(q_wt_up));
    f16* q_wt_down = p.wt_down; asm volatile("" : "+s"(q_wt_down));
    f16* q_poolWt = p.poolWt; asm volatile("" : "+s"(q_poolWt));
    f16* q_rWt = p.rWt; asm volatile("" : "+s"(q_rWt));
    f16* q_iWt = p.iWt; asm volatile("" : "+s"(q_iWt));
    const int tid = phase_tid(w0);
    CTile cur; CT_DESC(cur, lo); f32x4 va[4], vb[4];
    ct_load(cur, tid, va);
    for (int t = lo; t < hi; ++t) {
        CTile nxt; CT_DESC(nxt, (t + 1 < hi ? t + 1 : t));
        ct_load(nxt, tid, vb);
        ct_store(cur, tid, va, lds);
        cur = nxt;
#pragma unroll
        for (int i = 0; i < 4; ++i) va[i] = vb[i];
    }
}

__device__ __forceinline__ void norm_pre_phase(int blk, const float* __restrict__ x, const float* __restrict__ g, const float* __restrict__ scale, const float* __restrict__ shift, f16* __restrict__ h, int w0) {
    const int tid = phase_tid(w0), lane = tid & 63, wv = blk * 8 + __builtin_amdgcn_readfirstlane(tid >> 6);
    for (int t = wv; t < L; t += NBLK * 8) {
        const float* xr = x + (size_t)t * D; f32x4 v[8]; float ss = 0.f;
#pragma unroll
        for (int i = 0; i < 8; ++i) { v[i] = *(const f32x4*)(xr + (i * 64 + lane) * 4); ss += v[i][0] * v[i][0] + v[i][1] * v[i][1] + v[i][2] * v[i][2] + v[i][3] * v[i][3]; }
        ss = wave_sum(ss);
        const float r = rsqrtf(ss * (1.0f / D) + EPS);
#pragma unroll
        for (int i = 0; i < 8; ++i) { const int d = (i * 64 + lane) * 4;
            const f32x4 gg = *(const f32x4*)(g + d), sc = *(const f32x4*)(scale + d), sh = *(const f32x4*)(shift + d);
            const f32x4 o = v[i] * r * gg * (sc + 1.0f) + sh;
            *(u32x2*)(h + (size_t)t * D + d) = (u32x2){pack2(o[0], o[1]), pack2(o[2], o[3])}; }
    }
}
__device__ __forceinline__ void resid_norm_phase(int blk, const float* xi, const float* __restrict__ y, const float* __restrict__ gpost, const float* __restrict__ gate, float* xo,
                                                 const float* __restrict__ gpre, const float* __restrict__ scale, const float* __restrict__ shift, f16* __restrict__ h, int w0) {
    const int tid = phase_tid(w0), lane = tid & 63, wv = blk * 8 + __builtin_amdgcn_readfirstlane(tid >> 6);
    for (int t = wv; t < L; t += NBLK * 8) {
        const float* yr = y + (size_t)t * D; const float* xr = xi + (size_t)t * D; f32x4 v[8]; float ss = 0.f;
#pragma unroll
        for (int i = 0; i < 8; ++i) { v[i] = *(const f32x4*)(yr + (i * 64 + lane) * 4); ss += v[i][0] * v[i][0] + v[i][1] * v[i][1] + v[i][2] * v[i][2] + v[i][3] * v[i][3]; }
        ss = wave_sum(ss);
        const float r = rsqrtf(ss * (1.0f / D) + EPS);
        float s2 = 0.f;
#pragma unroll
        for (int i = 0; i < 8; ++i) { const int d = (i * 64 + lane) * 4;
            const f32x4 gg = *(const f32x4*)(gpost + d), gt = *(const f32x4*)(gate + d), xv = *(const f32x4*)(xr + d);
            v[i] = xv + gt * (v[i] * r * gg);
            *(f32x4*)(xo + (size_t)t * D + d) = v[i];
            s2 += v[i][0] * v[i][0] + v[i][1] * v[i][1] + v[i][2] * v[i][2] + v[i][3] * v[i][3]; }
        if (h) {
            s2 = wave_sum(s2);
            const float r2 = rsqrtf(s2 * (1.0f / D) + EPS);
#pragma unroll
            for (int i = 0; i < 8; ++i) { const int d = (i * 64 + lane) * 4;
                const f32x4 gg = *(const f32x4*)(gpre + d), sc = *(const f32x4*)(scale + d), sh = *(const f32x4*)(shift + d);
                const f32x4 o = v[i] * r2 * gg * (sc + 1.0f) + sh;
                *(u32x2*)(h + (size_t)t * D + d) = (u32x2){pack2(o[0], o[1]), pack2(o[2], o[3])}; }
        }
    }
}
namespace pg8 {
constexpr int BM = 256, BK = 64, HALF = 128, HTB = HALF * BK * 2  , STAGE_BYTES = 8 * HTB, NXCD = 8, WGM = 8;
__host__ __device__ __forceinline__ int lds_byte(int r, int c) { const int st = (r >> 4) * 2 + (c >> 5), rr = r & 15, cc = c & 31, ob = rr * 64 + cc * 2; return st * 1024 + (ob ^ (((ob >> 9) & 1) << 5)); }
__host__ __device__ __forceinline__ void stage_rc(int b, int& R, int& C) { const int st = b / 1024, sb = b % 1024, swz = sb ^ (((sb >> 9) & 1) << 5); R = (st >> 1) * 16 + swz / 64; C = (st & 1) * 32 + (swz % 64) / 2; }
__host__ __device__ __forceinline__ int perm32(int rho) { const int n = rho >> 4, i = rho & 15; return 8 * (i >> 2) + 4 * n + (i & 3); }
struct Unit { int pm, pn; };
struct Gemm { const f16* A; const f16* Bt; int M, N, K, wexp; };
struct StaticOrder {
    int nM, nN, nwg, G, c;
    __host__ __device__ void init(int M, int N, int G_, int c_) { nM = M / BM; nN = N / BM; nwg = nM * nN; G = G_; c = c_; }
    __host__ __device__ bool next(int i, Unit& u) const {
        const long Lx = (long)i * G + c; if (Lx >= nwg) return false;
        int wgid = (int)Lx; { const int q = nwg / NXCD, r = nwg % NXCD, xcd = wgid % NXCD, off = wgid / NXCD; wgid = (xcd < r ? xcd * (q + 1) : r * (q + 1) + (xcd - r) * q) + off; }
        const int nig = WGM * nN, gid = wgid / nig, fm = gid * WGM, gsz = (nM - fm) < WGM ? (nM - fm) : WGM;
        u.pm = fm + ((wgid % nig) % gsz); u.pn = (wgid % nig) / gsz; return true;
    }
    __device__ __forceinline__ void a_ready(const Unit&) const {}
    __device__ __forceinline__ void done(const Unit&) const {}
};

struct EpiF32 {
    static constexpr bool PERM = false, AFTER_DRAIN = false;
    float* C; int ldc, pad;
    __device__ __forceinline__ void operator()(const f32x4 (&acc)[2][2][4][2], const Unit& u, int wr, int wc, int fr, int fq) const {
        const int row0 = u.pm * BM + wr * 64 + fr, col0 = u.pn * BM + wc * 32 + 4 * fq;
#pragma unroll
        for (int ai = 0; ai < 2; ++ai)
#pragma unroll
            for (int m = 0; m < 4; ++m) { float* rowp = C + (size_t)(row0 + ai * HALF + m * 16) * ldc + col0;
#pragma unroll
                for (int bj = 0; bj < 2; ++bj)
#pragma unroll
                    for (int n = 0; n < 2; ++n) *(f32x4*)(rowp + bj * HALF + n * 16) = acc[ai][bj][m][n]; }
    }
};
struct EpiRelu2 {
    static constexpr bool PERM = true, AFTER_DRAIN = false;
    f16* O; int ldc, pad;
    __device__ __forceinline__ void operator()(const f32x4 (&acc)[2][2][4][2], const Unit& u, int wr, int wc, int fr, int fq) const {
        const int row0 = u.pm * BM + wr * 64 + fr, col0 = u.pn * BM + wc * 32 + 8 * fq;
#pragma unroll
        for (int ai = 0; ai < 2; ++ai)
#pragma unroll
            for (int m = 0; m < 4; ++m) { f16* rowp = O + (size_t)(row0 + ai * HALF + m * 16) * ldc + col0;
#pragma unroll
                for (int bj = 0; bj < 2; ++bj) { f32x4 v0 = acc[ai][bj][m][0], v1 = acc[ai][bj][m][1];
#pragma unroll
                    for (int j = 0; j < 4; ++j) { v0[j] = v0[j] > 0.f ? v0[j] * v0[j] : 0.f; v1[j] = v1[j] > 0.f ? v1[j] * v1[j] : 0.f; }
                    *(u32x4*)(rowp + bj * HALF) = (u32x4){pack2(v0[0], v0[1]), pack2(v0[2], v0[3]), pack2(v1[0], v1[1]), pack2(v1[2], v1[3])}; } }
    }
};
struct EpiRelu2F8 {
    static constexpr bool PERM = true, AFTER_DRAIN = false;
    unsigned char* O; int ldc, pad;
    __device__ __forceinline__ void operator()(const f32x4 (&acc)[2][2][4][2], const Unit& u, int wr, int wc, int fr, int fq) const {
        const int row0 = u.pm * BM + wr * 64 + fr, col0 = u.pn * BM + wc * 32 + 8 * fq;
#pragma unroll
        for (int ai = 0; ai < 2; ++ai)
#pragma unroll
            for (int m = 0; m < 4; ++m) { unsigned char* rowp = O + (size_t)(row0 + ai * HALF + m * 16) * ldc + col0;
#pragma unroll
                for (int bj = 0; bj < 2; ++bj) { f32x4 v0 = acc[ai][bj][m][0], v1 = acc[ai][bj][m][1];
#pragma unroll
                    for (int j = 0; j < 4; ++j) { v0[j] = v0[j] > 0.f ? fminf(v0[j] * v0[j], 448.f) : 0.f; v1[j] = v1[j] > 0.f ? fminf(v1[j] * v1[j], 448.f) : 0.f; }
                    unsigned w0 = 0u, w1 = 0u;
                    w0 = __builtin_amdgcn_cvt_pk_fp8_f32(v0[0], v0[1], w0, false); w0 = __builtin_amdgcn_cvt_pk_fp8_f32(v0[2], v0[3], w0, true);
                    w1 = __builtin_amdgcn_cvt_pk_fp8_f32(v1[0], v1[1], w1, false); w1 = __builtin_amdgcn_cvt_pk_fp8_f32(v1[2], v1[3], w1, true);
                    *(u32x2*)(rowp + bj * HALF) = (u32x2){w0, w1}; } }
    }
};
struct EpiProj {
    static constexpr bool PERM = true, AFTER_DRAIN = false;
    f16* qkv; f16* qi; f16* ki; float* wi; f16* pl; int pn0, pad;
    __device__ __forceinline__ void operator()(const f32x4 (&acc)[2][2][4][2], const Unit& u, int wr, int wc, int fr, int fq) const {
        const int pn = u.pn + pn0;
        const int row0 = u.pm * BM + wr * 64 + fr, colt = pn * BM, cl0 = wc * 32 + 8 * fq;
        if (pn < 4 || pn >= 11) {
#pragma unroll
            for (int ai = 0; ai < 2; ++ai)
#pragma unroll
                for (int m = 0; m < 4; ++m) { const int row = row0 + ai * HALF + m * 16;
#pragma unroll
                    for (int bj = 0; bj < 2; ++bj) { const f32x4 v0 = acc[ai][bj][m][0], v1 = acc[ai][bj][m][1]; const int c = colt + cl0 + bj * HALF;
                        f16* dst;
                        if (pn >= 11) { const int cq = c - 2816; dst = qkv + ((size_t)(cq >> 7) * L + row) * HD + (cq & 127); }
                        else dst = qi + (size_t)row * 1024 + c;
                        *(u32x4*)dst = (u32x4){pack2(v0[0], v0[1]), pack2(v0[2], v0[3]), pack2(v1[0], v1[1]), pack2(v1[2], v1[3])}; } }
        } else if (pn == 4) {
            if (cl0 < 80) {
#pragma unroll
                for (int ai = 0; ai < 2; ++ai)
#pragma unroll
                    for (int m = 0; m < 4; ++m) { const int row = row0 + ai * HALF + m * 16; const f32x4 v0 = acc[ai][0][m][0], v1 = acc[ai][0][m][1];
                        if (cl0 < 64) *(u32x4*)(ki + (size_t)row * 64 + cl0) = (u32x4){pack2(v0[0], v0[1]), pack2(v0[2], v0[3]), pack2(v1[0], v1[1]), pack2(v1[2], v1[3])};
                        else { float* wp = wi + (size_t)row * 16 + (cl0 - 64); *(f32x4*)wp = v0; *(f32x4*)(wp + 4) = v1; } }
            }
        } else {
            f16* rowb = pl + (size_t)row0 * 1536 + (colt - 1280 + cl0);
#pragma unroll
            for (int ai = 0; ai < 2; ++ai)
#pragma unroll
                for (int m = 0; m < 4; ++m) { f16* rowp = rowb + (size_t)(ai * HALF + m * 16) * 1536;
#pragma unroll
                    for (int bj = 0; bj < 2; ++bj) { const f32x4 v0 = acc[ai][bj][m][0], v1 = acc[ai][bj][m][1];
                        *(u32x4*)(rowp + bj * HALF) = (u32x4){pack2(v0[0], v0[1]), pack2(v0[2], v0[3]), pack2(v1[0], v1[1]), pack2(v1[2], v1[3])}; } }
        }
    }
};


struct RowStat { float* slots; unsigned* cnt; };
__device__ __forceinline__ void panel_rstd(const f32x4 (&v)[2][2][4][2], const RowStat& st, int pm, int pn, int wr, int wc, int fr, int fq, LAS unsigned char* lds, int wid, int lane) {
    LAS float* Pt = (LAS float*)lds;
    LAS float* Rt = (LAS float*)(lds + 4096);
#pragma unroll
    for (int ai = 0; ai < 2; ++ai)
#pragma unroll
        for (int m = 0; m < 4; ++m) { float s = 0.f;
#pragma unroll
            for (int bj = 0; bj < 2; ++bj)
#pragma unroll
                for (int n = 0; n < 2; ++n) { const f32x4 x = v[ai][bj][m][n]; s += (x[0] * x[0] + x[1] * x[1]) + (x[2] * x[2] + x[3] * x[3]); }
            s += swz_xor<16>(s); s = half_sum(s);
            if (fq == 0) Pt[(ai * HALF + wr * 64 + m * 16 + fr) * 4 + wc] = s; }
    asm volatile("s_waitcnt lgkmcnt(0)" ::: "memory"); __builtin_amdgcn_s_barrier(); asm volatile("" ::: "memory");
    const int row = wid * 32 + (lane & 31);
    if (lane < 32) { const float tot = (Pt[row * 4 + 0] + Pt[row * 4 + 1]) + (Pt[row * 4 + 2] + Pt[row * 4 + 3]);
        __hip_atomic_store((unsigned*)(st.slots + ((size_t)pm * BM + row) * 8 + pn), __float_as_uint(tot), __ATOMIC_RELAXED, __HIP_MEMORY_SCOPE_AGENT); }
    asm volatile("s_waitcnt vmcnt(0)" ::: "memory");
    if (lane == 0) __hip_atomic_fetch_add(st.cnt + 64 * pm, 1u, __ATOMIC_RELAXED, __HIP_MEMORY_SCOPE_AGENT);
    if (wid == 0) {
        unsigned sp = 0;
        while ((unsigned)__builtin_amdgcn_readfirstlane(__hip_atomic_load(st.cnt + 64 * pm, __ATOMIC_RELAXED, __HIP_MEMORY_SCOPE_AGENT)) < 64u) { __builtin_amdgcn_s_sleep(2); if (++sp > (1u << 22)) break; }
        __builtin_amdgcn_fence(__ATOMIC_ACQUIRE, "agent");
    }
    asm volatile("s_waitcnt vmcnt(0) lgkmcnt(0)" ::: "memory"); __builtin_amdgcn_s_barrier(); asm volatile("" ::: "memory");
    if (lane < 32) { const float* sl = st.slots + ((size_t)pm * BM + row) * 8; float q = 0.f;
#pragma unroll
        for (int t = 0; t < 8; ++t) q += __uint_as_float(__hip_atomic_load((const unsigned*)(sl + t), __ATOMIC_RELAXED, __HIP_MEMORY_SCOPE_AGENT));
        Rt[row] = rsqrtf(q * (1.0f / D) + EPS); }
    asm volatile("s_waitcnt lgkmcnt(0)" ::: "memory"); __builtin_amdgcn_s_barrier(); asm volatile("" ::: "memory");
}
struct EpiResNorm {
    static constexpr bool PERM = false, AFTER_DRAIN = true;
    const float* xi; float* xo; const float* mod; const float* gpost; const float* gpre; f16* h; float* slots; unsigned* cnt; int o_gate, o_scale, o_shift, use, h8, x16;
    __device__ __forceinline__ void fused(f32x4 (&acc)[2][2][4][2], const Unit& u, int wr, int wc, int fr, int fq, LAS unsigned char* lds, int wid, int lane) const {
        const LAS float* Rt = (const LAS float*)(lds + 4096);
        const int col0 = u.pn * BM + wc * 32 + 4 * fq;
        const float* gate = mod + o_gate; const float* scale = mod + o_scale; const float* shift = mod + o_shift;
        RowStat s1; s1.slots = slots + (size_t)use * (32 * 256 * 8); s1.cnt = cnt + (size_t)use * (32 * 64);
        RowStat s2; s2.slots = slots + (size_t)(use + 1) * (32 * 256 * 8); s2.cnt = cnt + (size_t)(use + 1) * (32 * 64);
        f32x4 xa[4], xb[4];
#define ERN_H4(p_) ({ const f16x4 h_ = *(const f16x4*)(p_); (f32x4){(float)h_[0], (float)h_[1], (float)h_[2], (float)h_[3]}; })
#define ERN_LDX(g_, X) do { const int r_ = ((g_) >> 2) * HALF + wr * 64 + ((g_) & 3) * 16 + fr; const size_t eo_ = (size_t)(u.pm * BM + r_) * D + col0;   \
            if (x16 & 1) { const f16* xh_ = (const f16*)xi + eo_; X[0] = ERN_H4(xh_); X[1] = ERN_H4(xh_ + 16); X[2] = ERN_H4(xh_ + HALF); X[3] = ERN_H4(xh_ + HALF + 16); }   \
            else { const float* xip_ = xi + eo_; X[0] = *(const f32x4*)(xip_); X[1] = *(const f32x4*)(xip_ + 16); X[2] = *(const f32x4*)(xip_ + HALF); X[3] = *(const f32x4*)(xip_ + HALF + 16); } } while (0)
        ERN_LDX(0, xa);
        f32x4 gg[2][2];
#pragma unroll
        for (int bj = 0; bj < 2; ++bj)
#pragma unroll
            for (int n = 0; n < 2; ++n) { const int c = col0 + bj * HALF + n * 16; const f32x4 g4 = *(const f32x4*)(gpost + c), t4 = *(const f32x4*)(gate + c);
                gg[bj][n] = (f32x4){g4[0] * t4[0], g4[1] * t4[1], g4[2] * t4[2], g4[3] * t4[3]}; }
        panel_rstd(acc, s1, u.pm, u.pn, wr, wc, fr, fq, lds, wid, lane);
#define ERN_GRP(g_, X) do { const int ai_ = (g_) >> 2, m_ = (g_) & 3; const int r_ = ai_ * HALF + wr * 64 + m_ * 16 + fr; const float rs_ = Rt[r_]; const size_t eo_ = (size_t)(u.pm * BM + r_) * D + col0; float* xop_ = xo + eo_;  \
            _Pragma("unroll") for (int bj = 0; bj < 2; ++bj) _Pragma("unroll") for (int n = 0; n < 2; ++n) { const f32x4 x4 = X[bj * 2 + n]; f32x4 a4 = acc[ai_][bj][m_][n]; const f32x4 q4 = gg[bj][n];   \
                a4[0] = fmaf(a4[0] * rs_, q4[0], x4[0]); a4[1] = fmaf(a4[1] * rs_, q4[1], x4[1]); a4[2] = fmaf(a4[2] * rs_, q4[2], x4[2]); a4[3] = fmaf(a4[3] * rs_, q4[3], x4[3]);                \
                acc[ai_][bj][m_][n] = a4;                                                                                                                                                       \
                if (x16 & 2) *(u32x2*)((f16*)xo + eo_ + bj * HALF + n * 16) = (u32x2){pack2(a4[0], a4[1]), pack2(a4[2], a4[3])}; else *(f32x4*)(xop_ + bj * HALF + n * 16) = a4; }                \
            asm volatile("" ::: "memory"); } while (0)
        ERN_LDX(1, xb); ERN_GRP(0, xa);
        ERN_LDX(2, xa); ERN_GRP(1, xb);
        ERN_LDX(3, xb); ERN_GRP(2, xa);
        ERN_LDX(4, xa); ERN_GRP(3, xb);
        ERN_LDX(5, xb); ERN_GRP(4, xa);
        ERN_LDX(6, xa); ERN_GRP(5, xb);
        ERN_LDX(7, xb); ERN_GRP(6, xa);
        ERN_GRP(7, xb);
#undef ERN_LDX
#undef ERN_H4
#undef ERN_GRP
        if (h) {
            f32x4 gq[2][2], bq[2][2];
#pragma unroll
            for (int bj = 0; bj < 2; ++bj)
#pragma unroll
                for (int n = 0; n < 2; ++n) { const int c = col0 + bj * HALF + n * 16; const f32x4 g4 = *(const f32x4*)(gpre + c), s4 = *(const f32x4*)(scale + c);
                    bq[bj][n] = *(const f32x4*)(shift + c);
                    gq[bj][n] = (f32x4){g4[0] * (s4[0] + 1.0f), g4[1] * (s4[1] + 1.0f), g4[2] * (s4[2] + 1.0f), g4[3] * (s4[3] + 1.0f)}; }
            panel_rstd(acc, s2, u.pm, u.pn, wr, wc, fr, fq, lds, wid, lane);
#pragma unroll
            for (int ai = 0; ai < 2; ++ai)
#pragma unroll
                for (int m = 0; m < 4; ++m) { const int r = ai * HALF + wr * 64 + m * 16 + fr; const float rs = Rt[r]; const size_t off = (size_t)(u.pm * BM + r) * D + col0;
#pragma unroll
                    for (int bj = 0; bj < 2; ++bj)
#pragma unroll
                        for (int n = 0; n < 2; ++n) {
                            f32x4 o4;
#pragma unroll
                            for (int j = 0; j < 4; ++j) o4[j] = fmaf(acc[ai][bj][m][n][j] * rs, gq[bj][n][j], bq[bj][n][j]);
                            asm volatile("" : "+v"(o4));
                            if (h8) { _Pragma("unroll") for (int j = 0; j < 4; ++j) o4[j] = __builtin_amdgcn_fmed3f(o4[j], -448.f, 448.f);
                                      unsigned w8 = 0u; w8 = __builtin_amdgcn_cvt_pk_fp8_f32(o4[0], o4[1], w8, false); w8 = __builtin_amdgcn_cvt_pk_fp8_f32(o4[2], o4[3], w8, true); *(unsigned*)((unsigned char*)h + off + bj * HALF + n * 16) = w8; }
                            else *(u32x2*)(h + off + bj * HALF + n * 16) = (u32x2){pack2(o4[0], o4[1]), pack2(o4[2], o4[3])}; }
                    asm volatile("" ::: "memory"); }
        }
    }
};

template <class Epi, class Sched, bool ALIGN_EPI = true, bool SP2 = true, bool F8 = false>
__device__ __forceinline__ void gemm_phase(LAS unsigned char* lds, const Gemm g, const Sched& S, const Epi& E, int w0) {
    const int tid = phase_tid(w0), wid = __builtin_amdgcn_readfirstlane(tid >> 6), lane = tid & 63, wr = wid >> 2, wc = wid & 3, fr = lane & 15, fq = lane >> 4;
    const int K = g.K, nt = F8 ? K / 128 : K / BK; constexpr unsigned EB = F8 ? 1u : 2u;
    unsigned voffA[2], voffB[2];
#pragma unroll
    for (int i = 0; i < 2; ++i) { int R, C; stage_rc(tid * 16 + i * 8192, R, C); const int Rb = Epi::PERM ? ((R & ~31) + perm32(R & 31)) : R;
        voffA[i] = (unsigned)(R * K) * EB + (unsigned)C * 2u; voffB[i] = (unsigned)(Rb * K) * EB + (unsigned)C * 2u; }
    const size_t kstep = (size_t)(BK * 2);
    const size_t hstep = (size_t)HALF * K * EB;
    const size_t tstep = 2 * hstep;
    const unsigned ldsw = (unsigned)wid * 1024u;
    const int aoff = lds_byte(wr * 64 + fr, fq * 8), boff = lds_byte(wc * 32 + fr, fq * 8);
#define PG8_SA(b, h) (((b) * 2 + (h)) * HTB)
#define PG8_SB(b, h) ((4 + (b) * 2 + (h)) * HTB)
#define PG8_STAGE(bufoff, gbase, voff) do { _Pragma("unroll") for (int _i = 0; _i < 2; ++_i) \
        __builtin_amdgcn_global_load_lds((const unsigned*)((const char*)(gbase) + (voff)[_i]), (LAS unsigned*)(lds + (bufoff) + ldsw + _i * 8192), 16, 0, 0); } while (0)
#define PG8_LDA(dst, b, h) do { if constexpr (F8) { _Pragma("unroll") for (int m = 0; m < 4; ++m) { const u32x4 lo_ = *(const LAS u32x4*)(lds + PG8_SA(b, h) + aoff8_0 + m * 2048), hi_ = *(const LAS u32x4*)(lds + PG8_SA(b, h) + aoff8_0 + aoff8_1d + m * 2048); \
            dst##8[m] = __builtin_bit_cast(v8i_t, __builtin_shufflevector(lo_, hi_, 0, 1, 2, 3, 4, 5, 6, 7)); } } \
        else { _Pragma("unroll") for (int m = 0; m < 4; ++m) _Pragma("unroll") for (int k = 0; k < 2; ++k) dst[m][k] = *(const LAS f16x8*)(lds + PG8_SA(b, h) + aoff + m * 2048 + k * 1024); } } while (0)
#define PG8_LDB(dst, b, h) do { if constexpr (F8) { _Pragma("unroll") for (int n = 0; n < 2; ++n) { const u32x4 lo_ = *(const LAS u32x4*)(lds + PG8_SB(b, h) + boff8_0 + n * 2048), hi_ = *(const LAS u32x4*)(lds + PG8_SB(b, h) + boff8_0 + boff8_1d + n * 2048); \
            dst##8[n] = __builtin_bit_cast(v8i_t, __builtin_shufflevector(lo_, hi_, 0, 1, 2, 3, 4, 5, 6, 7)); } } \
        else { _Pragma("unroll") for (int n = 0; n < 2; ++n) _Pragma("unroll") for (int k = 0; k < 2; ++k) dst[n][k] = *(const LAS f16x8*)(lds + PG8_SB(b, h) + boff + n * 2048 + k * 1024); } } while (0)
#define PG8_MMA(ai, bj, At, Bt) do { __builtin_amdgcn_s_setprio(1); \
        if constexpr (F8) { _Pragma("unroll") for (int m = 0; m < 4; ++m) _Pragma("unroll") for (int n = 0; n < 2; ++n) \
            asm volatile("v_mfma_scale_f32_16x16x128_f8f6f4 %0, %1, %2, %0, %3, %4 op_sel_hi:[0,0,0]" : "+v"(acc[ai][bj][m][n]) : "v"(Bt##8[n]), "v"(At##8[m]), "v"(sc_w8), "v"(sc_a8)); } \
        else { _Pragma("unroll") for (int m = 0; m < 4; ++m) _Pragma("unroll") for (int n = 0; n < 2; ++n) _Pragma("unroll") for (int k = 0; k < 2; ++k) \
            acc[ai][bj][m][n] = __builtin_amdgcn_mfma_f32_16x16x32_f16(Bt[n][k], At[m][k], acc[ai][bj][m][n], 0, 0, 0); } \
        __builtin_amdgcn_s_setprio(0); } while (0)
#define PG8_WAIT_V(n) asm volatile("s_waitcnt vmcnt(" #n ")" ::: "memory")
#define PG8_WAIT_L(n) asm volatile("s_waitcnt lgkmcnt(" #n ")" ::: "memory")
#define PG8_BAR __builtin_amdgcn_s_barrier()
#define PG8_SCHED __builtin_amdgcn_sched_barrier(0)
    Unit cur, nxt; int ui = 0;
    if (!S.next(0, cur)) return;
    f32x4 acc[2][2][4][2];
#pragma unroll
    for (int a = 0; a < 2; ++a)
#pragma unroll
        for (int b = 0; b < 2; ++b)
#pragma unroll
            for (int m = 0; m < 4; ++m)
#pragma unroll
                for (int n = 0; n < 2; ++n) acc[a][b][m][n] = (f32x4){0.f, 0.f, 0.f, 0.f};
    f16x8 At[4][2], B0[2][2], B1[2][2];
    typedef int v8i_t __attribute__((ext_vector_type(8)));
    const int sc_w8 = g.wexp, sc_a8 = 127;
    v8i_t At8[4], B08[2], B18[2];
    const int aoff8_0 = lds_byte(wr * 64 + fr, (2 * (fq & 1)) * 8) + (fq >> 1) * 1024, boff8_0 = lds_byte(wc * 32 + fr, (2 * (fq & 1)) * 8) + (fq >> 1) * 1024;
    constexpr int aoff8_1d = 16, boff8_1d = 16;
    const char* cA = (const char*)g.A + (size_t)cur.pm * tstep; const char* cB = (const char*)g.Bt + (size_t)cur.pn * tstep;
    S.a_ready(cur);
    if constexpr (SP2) {
        PG8_STAGE(PG8_SB(0, 0), cB, voffB); PG8_STAGE(PG8_SB(0, 1), cB + hstep, voffB); PG8_STAGE(PG8_SA(0, 0), cA, voffA); PG8_STAGE(PG8_SA(0, 1), cA + hstep, voffA);
        if (wr == 1) PG8_BAR;
        PG8_WAIT_V(2); PG8_BAR;
        PG8_STAGE(PG8_SB(1, 0), cB + kstep, voffB); PG8_STAGE(PG8_SA(1, 0), cA + kstep, voffA); PG8_STAGE(PG8_SB(1, 1), cB + hstep + kstep, voffB);
        PG8_WAIT_V(6); PG8_BAR;
    } else {
        PG8_STAGE(PG8_SB(0, 0), cB, voffB); PG8_STAGE(PG8_SA(0, 0), cA, voffA); PG8_STAGE(PG8_SB(0, 1), cB + hstep, voffB); PG8_STAGE(PG8_SA(0, 1), cA + hstep, voffA);
        if (wr == 1) PG8_BAR;
        PG8_WAIT_V(4); PG8_BAR;
        PG8_STAGE(PG8_SB(1, 0), cB + kstep, voffB); PG8_STAGE(PG8_SA(1, 0), cA + kstep, voffA); PG8_STAGE(PG8_SB(1, 1), cB + hstep + kstep, voffB);
        PG8_WAIT_V(6); PG8_BAR;
    }
    for (;;) {
        const bool has_next = S.next(ui + 1, nxt);
        const char* nA = has_next ? (const char*)g.A + (size_t)nxt.pm * tstep : cA; const char* nB = has_next ? (const char*)g.Bt + (size_t)nxt.pn * tstep : cB;
        for (int t = 0; t < nt; t += 2) {
            const bool last = (t == nt - 2);
            const char* a1 = cA + (size_t)(t + 1) * kstep;
            const char* a2 = last ? nA : cA + (size_t)(t + 2) * kstep; const char* b2 = last ? nB : cB + (size_t)(t + 2) * kstep;
            const char* a3 = a2 + kstep; const char* b3 = b2 + kstep;
            if (last && has_next) S.a_ready(nxt);
            if constexpr (SP2) {
            PG8_LDB(B0, 0, 0); PG8_LDB(B1, 0, 1); PG8_SCHED; PG8_LDA(At, 0, 0); PG8_STAGE(PG8_SA(1, 1), a1 + hstep, voffA);
            PG8_WAIT_V(8); PG8_WAIT_L(0); PG8_BAR; PG8_MMA(0, 0, At, B0); PG8_MMA(0, 1, At, B1); PG8_BAR; PG8_SCHED;
            PG8_LDA(At, 0, 1); PG8_STAGE(PG8_SB(0, 0), b2, voffB); PG8_STAGE(PG8_SB(0, 1), b2 + hstep, voffB); PG8_STAGE(PG8_SA(0, 0), a2, voffA);
            PG8_WAIT_V(8); PG8_WAIT_L(0); PG8_BAR; PG8_MMA(1, 0, At, B0); PG8_MMA(1, 1, At, B1); PG8_BAR; PG8_SCHED;
            PG8_LDB(B0, 1, 0); PG8_LDB(B1, 1, 1); PG8_SCHED; PG8_LDA(At, 1, 0); PG8_STAGE(PG8_SA(0, 1), a2 + hstep, voffA);
            PG8_WAIT_V(8); PG8_WAIT_L(0); PG8_BAR; PG8_MMA(0, 0, At, B0); PG8_MMA(0, 1, At, B1); PG8_BAR; PG8_SCHED;
            PG8_LDA(At, 1, 1); PG8_STAGE(PG8_SB(1, 0), b3, voffB); PG8_STAGE(PG8_SB(1, 1), b3 + hstep, voffB); PG8_STAGE(PG8_SA(1, 0), a3, voffA);
            PG8_WAIT_V(8); PG8_WAIT_L(0); PG8_BAR; PG8_MMA(1, 0, At, B0); PG8_MMA(1, 1, At, B1); PG8_BAR; PG8_SCHED;
            } else {
            PG8_LDB(B0, 0, 0); PG8_SCHED; PG8_LDA(At, 0, 0); PG8_STAGE(PG8_SA(1, 1), a1 + hstep, voffA);
            PG8_WAIT_L(8); PG8_BAR; PG8_WAIT_L(0); PG8_MMA(0, 0, At, B0); PG8_BAR; PG8_SCHED;
            PG8_LDB(B1, 0, 1); PG8_STAGE(PG8_SB(0, 0), b2, voffB);
            PG8_BAR; PG8_WAIT_L(0); PG8_MMA(0, 1, At, B1); PG8_BAR;
            PG8_LDA(At, 0, 1); PG8_STAGE(PG8_SA(0, 0), a2, voffA);
            PG8_BAR; PG8_WAIT_L(0); PG8_MMA(1, 0, At, B0); PG8_BAR; PG8_SCHED;
            PG8_STAGE(PG8_SB(0, 1), b2 + hstep, voffB);
            PG8_WAIT_V(6); PG8_BAR; PG8_MMA(1, 1, At, B1); PG8_BAR;
            PG8_LDB(B0, 1, 0); PG8_SCHED; PG8_LDA(At, 1, 0); PG8_STAGE(PG8_SA(0, 1), a2 + hstep, voffA);
            PG8_WAIT_L(8); PG8_BAR; PG8_WAIT_L(0); PG8_MMA(0, 0, At, B0); PG8_BAR; PG8_SCHED;
            PG8_LDB(B1, 1, 1); PG8_STAGE(PG8_SB(1, 0), b3, voffB);
            PG8_BAR; PG8_WAIT_L(0); PG8_MMA(0, 1, At, B1); PG8_BAR;
            PG8_LDA(At, 1, 1); PG8_STAGE(PG8_SA(1, 0), a3, voffA);
            PG8_BAR; PG8_WAIT_L(0); PG8_MMA(1, 0, At, B0); PG8_BAR; PG8_SCHED;
            PG8_STAGE(PG8_SB(1, 1), b3 + hstep, voffB);
            PG8_WAIT_V(6); PG8_BAR; PG8_MMA(1, 1, At, B1); PG8_BAR;
            }
        }
        if constexpr (F8) asm volatile("s_nop 15\n\ts_nop 15" ::: "memory");
        if constexpr (ALIGN_EPI) { if (wr == 0) PG8_BAR; }
        if constexpr (!Epi::AFTER_DRAIN) { E(acc, cur, wr, wc, fr, fq); S.done(cur); }
        if (!has_next) break;
#pragma unroll
        for (int a = 0; a < 2; ++a)
#pragma unroll
            for (int b = 0; b < 2; ++b)
#pragma unroll
                for (int m = 0; m < 4; ++m)
#pragma unroll
                    for (int n = 0; n < 2; ++n) acc[a][b][m][n] = (f32x4){0.f, 0.f, 0.f, 0.f};
        cur = nxt; cA = nA; cB = nB; ++ui;
        if constexpr (ALIGN_EPI) { if (wr == 1) PG8_BAR; }
    }
    PG8_WAIT_V(0);
    if constexpr (!ALIGN_EPI) { if (wr == 0) PG8_BAR; }
    PG8_BAR;
    if constexpr (Epi::AFTER_DRAIN) { const int t2_ = phase_tid(w0), l2_ = t2_ & 63;
        E.fused(acc, cur, wr, wc, l2_ & 15, l2_ >> 4, lds, wid, l2_); S.done(cur); }
#undef PG8_SA
#undef PG8_SB
#undef PG8_STAGE
#undef PG8_LDA
#undef PG8_LDB
#undef PG8_MMA
#undef PG8_WAIT_V
#undef PG8_WAIT_L
#undef PG8_BAR
#undef PG8_SCHED
}
}
__device__ __forceinline__ int wave_sum_dpp(int v) {
    v += __builtin_amdgcn_update_dpp(0, v, 0xB1, 0xF, 0xF, false);
    v += __builtin_amdgcn_update_dpp(0, v, 0x4E, 0xF, 0xF, false);
    v += __builtin_amdgcn_update_dpp(0, v, 0x141, 0xF, 0xF, false);
    v += __builtin_amdgcn_update_dpp(0, v, 0x140, 0xF, 0xF, false);
    v += __builtin_amdgcn_update_dpp(0, v, 0x142, 0xA, 0xF, false);
    v += __builtin_amdgcn_update_dpp(0, v, 0x143, 0xC, 0xF, false);
    return __builtin_amdgcn_readlane(v, 63);
}
__device__ __forceinline__ uint32_t wave_max_dpp(uint32_t v) {
#define MX_(c, rm) { const uint32_t o_ = (uint32_t)__builtin_amdgcn_update_dpp(0, (int)v, c, rm, 0xF, false); v = o_ > v ? o_ : v; }
    MX_(0xB1, 0xF) MX_(0x4E, 0xF) MX_(0x141, 0xF) MX_(0x140, 0xF) MX_(0x142, 0xA) MX_(0x143, 0xC)
#undef MX_
    return (uint32_t)__builtin_amdgcn_readlane((int)v, 63);
}
__device__ __forceinline__ float wave_sum_f_dpp(float v) {
#define FS_(c, rm) v += __int_as_float(__builtin_amdgcn_update_dpp(0, __float_as_int(v), c, rm, 0xF, false));
    FS_(0xB1, 0xF) FS_(0x4E, 0xF) FS_(0x141, 0xF) FS_(0x140, 0xF) FS_(0x142, 0xA) FS_(0x143, 0xC)
#undef FS_
    return __int_as_float(__builtin_amdgcn_readlane(__float_as_int(v), 63));
}
__device__ __forceinline__ int wave_incl_scan_dpp(int v) {
    v += __builtin_amdgcn_update_dpp(0, v, 0x111, 0xF, 0xF, false);
    v += __builtin_amdgcn_update_dpp(0, v, 0x112, 0xF, 0xF, false);
    v += __builtin_amdgcn_update_dpp(0, v, 0x114, 0xF, 0xF, false);
    v += __builtin_amdgcn_update_dpp(0, v, 0x118, 0xF, 0xF, false);
    v += __builtin_amdgcn_update_dpp(0, v, 0x142, 0xA, 0xF, false);
    v += __builtin_amdgcn_update_dpp(0, v, 0x143, 0xC, 0xF, false);
    return v;
}
__device__ __forceinline__ void cnt4(int& acc, uint32_t cand, uint32_t k0, uint32_t k1, uint32_t k2, uint32_t k3) {
    unsigned long long m1, m2, m3;
    asm("v_cmp_le_u32_e64 vcc, %4, %5\n\tv_cmp_le_u32_e64 %1, %4, %6\n\tv_cmp_le_u32_e64 %2, %4, %7\n\tv_cmp_le_u32_e64 %3, %4, %8\n\t"
        "v_addc_co_u32_e64 %0, vcc, 0, %0, vcc\n\tv_addc_co_u32_e64 %0, %1, 0, %0, %1\n\tv_addc_co_u32_e64 %0, %2, 0, %0, %2\n\tv_addc_co_u32_e64 %0, %3, 0, %0, %3"
        : "+v"(acc), "=&s"(m1), "=&s"(m2), "=&s"(m3) : "s"(cand), "v"(k0), "v"(k1), "v"(k2), "v"(k3) : "vcc");
}
__device__ __forceinline__ void cnt2(int& acc, uint32_t cand, uint32_t k0, uint32_t k1) {
    unsigned long long m1;
    asm("v_cmp_le_u32_e64 vcc, %2, %3\n\tv_cmp_le_u32_e64 %1, %2, %4\n\ts_nop 0\n\t"
        "v_addc_co_u32_e64 %0, vcc, 0, %0, vcc\n\tv_addc_co_u32_e64 %0, %1, 0, %0, %1"
        : "+v"(acc), "=&s"(m1) : "s"(cand), "v"(k0), "v"(k1) : "vcc");
}
__device__ __forceinline__ void cnt4f(int& acc, uint32_t g, uint32_t k0, uint32_t k1, uint32_t k2, uint32_t k3) {
    unsigned long long m1, m2, m3;
    asm("v_cmp_le_f32_e64 vcc, %4, %5\n\tv_cmp_le_f32_e64 %1, %4, %6\n\tv_cmp_le_f32_e64 %2, %4, %7\n\tv_cmp_le_f32_e64 %3, %4, %8\n\t"
        "v_addc_co_u32_e64 %0, vcc, 0, %0, vcc\n\tv_addc_co_u32_e64 %0, %1, 0, %0, %1\n\tv_addc_co_u32_e64 %0, %2, 0, %0, %2\n\tv_addc_co_u32_e64 %0, %3, 0, %0, %3"
        : "+v"(acc), "=&s"(m1), "=&s"(m2), "=&s"(m3) : "s"(g), "v"(k0), "v"(k1), "v"(k2), "v"(k3) : "vcc");
}
__device__ __forceinline__ uint32_t okey(uint32_t u) { return u ^ ((uint32_t)((int)u >> 31) | 0x80000000u); }
__device__ __forceinline__ uint32_t okey_inv(uint32_t k) { return k ^ ((uint32_t)(~(int)k >> 31) | 0x80000000u); }
constexpr uint32_t SEL_NAN = 0x7FC00000u;
constexpr int SEL_CAP = 1024, SEL_WLDS = (SEL_CAP + 64) * 8 + 1024;

#define SEL_LOAD(t_) do { const int sm_ = (t_) >> 6, sodd_ = ((t_) >> 5) & 1;        \
        const float* row_ = S + (size_t)__builtin_amdgcn_readfirstlane((sodd_ ? (sm_ + 1) * (sm_ + 1) : sm_ * (sm_ + 1)) * 2048 + ((t_) & 31) * 64);     \
        const __amdgpu_buffer_rsrc_t rs_ = __builtin_amdgcn_make_buffer_rsrc((void*)row_, (short)0, (int)0x7FFFFFFF, 0x00020000);     \
        const int NGl_ = (t_) < TOPK ? 0 : ((t_) >> 10) + 1;                                                                 \
        _Pragma("unroll") for (int g = 0; g < 8; ++g) {                                                                    \
            if (g < NGl_) { _Pragma("unroll") for (int j = 0; j < 16; ++j) key[g * 16 + j] = __builtin_amdgcn_raw_buffer_load_b32(rs_, lane4, (g * 16 + j) * 8192, 0); }   \
            else { _Pragma("unroll") for (int j = 0; j < 16; ++j) key[g * 16 + j] = 0u; } } } while (0)
#define PIN16K(b) asm volatile("" : "+v"(key[(b)+0]), "+v"(key[(b)+1]), "+v"(key[(b)+2]), "+v"(key[(b)+3]), "+v"(key[(b)+4]), "+v"(key[(b)+5]), "+v"(key[(b)+6]), "+v"(key[(b)+7]), \
                                   "+v"(key[(b)+8]), "+v"(key[(b)+9]), "+v"(key[(b)+10]), "+v"(key[(b)+11]), "+v"(key[(b)+12]), "+v"(key[(b)+13]), "+v"(key[(b)+14]), "+v"(key[(b)+15]))
#define SEL_PIN() do { PIN16K(0); PIN16K(16); PIN16K(32); PIN16K(48); PIN16K(64); PIN16K(80); PIN16K(96); PIN16K(112); } while (0)

__device__ __forceinline__ uint32_t sel_thr(uint32_t cand) { return cand <= 0x007FFFFFu ? 0xFF800000u : okey_inv(cand); }
__device__ __forceinline__ void sel_full(const uint32_t (&key)[128], int NG, int lane, unsigned long long& wlo, unsigned long long& whi) {
    uint32_t prefix = 0u; bool exact = false;
    for (int bit = 31; bit >= 0; --bit) {
        const uint32_t cand = prefix | (1u << bit); const uint32_t gf = sel_thr(cand);
        int cl = 0;
#pragma unroll
        for (int g = 0; g < 8; ++g) {
            if (g < NG) {
#pragma unroll
                for (int j = 0; j < 16; j += 4) cnt4f(cl, gf, key[g * 16 + j], key[g * 16 + j + 1], key[g * 16 + j + 2], key[g * 16 + j + 3]);
            }
        }
        const int cnt = wave_sum_dpp(cl);
        if (cnt >= TOPK) prefix = cand;
        if (cnt == TOPK) { exact = true; break; }
    }
    const float tf = __uint_as_float(sel_thr(prefix));
    wlo = 0ull; whi = 0ull;
    if (exact) {
#pragma unroll
        for (int i = 0; i < 128; ++i) {
            const unsigned long long b = ((i >> 4) < NG) ? __ballot(tf <= __uint_as_float(key[i])) : 0ull;
            if (i < 64) { if (lane == i) wlo = b; } else { if (lane == i - 64) whi = b; }
        }
    } else {
        int cl = 0;
#pragma unroll
        for (int i = 0; i < 128; ++i) cl += ((i >> 4) < NG && tf < __uint_as_float(key[i])) ? 1 : 0;
        cl = wave_sum_dpp(cl);
        int need = TOPK - cl;
        const unsigned long long lt = (lane == 0) ? 0ull : ((~0ull) >> (64 - lane));
        float tf1 = tf; asm volatile("" : "+v"(tf1));
#pragma unroll
        for (int i = 0; i < 128; ++i) {
            const bool ing = (i >> 4) < NG; const float fi = __uint_as_float(key[i]);
            const unsigned long long eq = ing ? __ballot(fi == tf1) : 0ull;
            const int rank = __popcll(eq & lt);
            const bool sel = ing && ((tf1 < fi) || (fi == tf1 && rank < need));
            need -= __popcll(eq); if (need < 0) need = 0;
            const unsigned long long b = __ballot(sel);
            if (i < 64) { if (lane == i) wlo = b; } else { if (lane == i - 64) whi = b; }
        }
    }
}

__device__ __forceinline__ void select_phase(int blk, const float* __restrict__ S, unsigned long long* __restrict__ mask, LAS unsigned char* lds, int w0, f16* poison = nullptr) {
    const int tid = phase_tid(w0), lane = tid & 63, g8 = __builtin_amdgcn_readfirstlane(tid >> 6), gq = blk * 8 + g8;
    LAS unsigned char* wl = lds + g8 * SEL_WLDS;
    LAS uint32_t* prl = (LAS uint32_t*)wl; LAS uint32_t* pil = (LAS uint32_t*)(wl + (SEL_CAP + 64) * 4); LAS uint32_t* rowb = (LAS uint32_t*)(wl + (SEL_CAP + 64) * 8);
    (void)poison;
    uint32_t key[128];
    const int lane4 = lane * 4;
    SEL_LOAD(gq);
#pragma unroll 1
    for (int k = 0; k < 4; ++k) {
        const int t = (k == 0) ? gq : (k == 1) ? 4095 - gq : (k == 2) ? 4096 + gq : 8191 - gq;
        const int tn = (k == 0) ? 4095 - gq : (k == 1) ? 4096 + gq : 8191 - gq;
        unsigned long long* mrow = mask + (size_t)t * 128;
        if (t < TOPK) {
            for (int i = lane; i < 128; i += 64) {
                const int lo = i * 64; unsigned long long w = 0ull;
                if (t >= lo + 63) w = ~0ull; else if (t >= lo) w = (~0ull) >> (63 - (t - lo));
                mrow[i] = w;
            }
            SEL_LOAD(tn);
            continue;
        }
        const int NG = (t >> 10) + 1;
        int lane_k = lane; asm volatile("" : "+v"(lane_k));
        SEL_PIN();
#pragma unroll
        for (int g = 0; g < 8; ++g) {
            if (g == NG - 1) {
#pragma unroll
                for (int j = 0; j < 16; ++j) { const int idx = (g * 16 + j) * 64 + lane_k; key[g * 16 + j] = idx <= t ? key[g * 16 + j] : SEL_NAN; }
            }
        }
        uint32_t G = 0xFF800000u;
        int cg = 0, incl = 0, C = 0; bool fast = false;
#pragma unroll 1
        for (int att = 0; att < 2; ++att) {
            if (NG >= 2) {
                if (att == 0) {
                    float s1 = 0.f, s2 = 0.f; int n = 0;
#pragma unroll
                    for (int g = 0; g < 8; ++g) {
                        if (g < NG) {
#pragma unroll
                            for (int r = 4; r < 16; r += 8) { const float fr = __uint_as_float(key[16 * g + r]); const bool ok = fr == fr;
                                const float fv = ok ? fr : 0.f; s1 += fv; s2 = fmaf(fv, fv, s2); n += ok ? 1 : 0; }
                        }
                    }
                    const float S1 = wave_sum_f_dpp(s1), S2 = wave_sum_f_dpp(s2); const float N = (float)wave_sum_dpp(n);
                    const float mean = S1 / N, var = S2 / N - mean * mean, sd = __builtin_sqrtf(fmaxf(var, 0.f));
                    float p = 80.f / N; const bool up = p <= 0.5f; p = up ? p : 1.f - p; p = fmaxf(p, 1e-6f);
                    const float tt = __builtin_sqrtf(-2.f * __logf(p));
                    float z = tt - (2.515517f + tt * (0.802853f + tt * 0.010328f)) / (1.f + tt * (1.432788f + tt * (0.189269f + tt * 0.001308f)));
                    z = up ? z : -z;
                    const float gf = mean + z * sd;
                    G = __builtin_amdgcn_readfirstlane(__float_as_uint(gf));
                } else {
                    uint32_t sk[16];
#pragma unroll
                    for (int g = 0; g < 8; ++g) {
#pragma unroll
                        for (int r = 0; r < 2; ++r) { const uint32_t u = key[16 * g + 4 + 8 * r]; sk[2 * g + r] = (g < NG && __uint_as_float(u) == __uint_as_float(u)) ? okey(u) : 0u; }
                    }
                    uint32_t pre = 0u;
                    for (int bit = 31; bit >= 12; --bit) {
                        const uint32_t cand = pre | (1u << bit);
                        int cl = 0;
#pragma unroll
                        for (int m = 0; m < 16; m += 4) cnt4(cl, cand, sk[m], sk[m + 1], sk[m + 2], sk[m + 3]);
                        const int cnt = wave_sum_dpp(cl);
                        if (cnt >= 80) pre = cand;
                        if (cnt == 80) break;
                    }
                    G = pre ? okey_inv(pre) : SEL_NAN;
                }
            }
            cg = 0;
#pragma unroll
            for (int g = 0; g < 8; ++g) {
                if (g < NG) {
#pragma unroll
                    for (int j = 0; j < 16; j += 4) cnt4f(cg, G, key[g * 16 + j], key[g * 16 + j + 1], key[g * 16 + j + 2], key[g * 16 + j + 3]);
                }
            }
            incl = wave_incl_scan_dpp(cg);
            C = __builtin_amdgcn_readlane(incl, 63);
            fast = (C >= TOPK) && (C <= SEL_CAP);
            if (fast || NG < 2) break;
        }
        if (!fast) {
            unsigned long long wlo, whi; sel_full(key, NG, lane_k, wlo, whi);
            mrow[lane_k] = wlo; mrow[64 + lane_k] = whi;
        } else {
            int lane_c = lane_k; asm volatile("" : "+v"(lane_c));
            int pos = incl - cg; const int trash = SEL_CAP + lane_c;
            uint32_t G2 = G; asm volatile("" : "+s"(G2));
#pragma unroll
            for (int g = 0; g < 8; ++g) {
                if (g < NG) {
#pragma unroll
                    for (int j = 0; j < 16; ++j) {
                        const int i = g * 16 + j; const bool p = __uint_as_float(G2) <= __uint_as_float(key[i]);
                        const int a = p ? pos : trash;
                        prl[a] = key[i]; pil[a] = (unsigned)(i * 64 + lane_c);
                        pos += p ? 1 : 0;
                    }
                }
            }
        }
#ifdef SEL_CHECK
        unsigned chk_h = 0u;
        if (fast) { unsigned long long chk_lo = 0ull, chk_hi = 0ull; sel_full(key, NG, lane_k, chk_lo, chk_hi); chk_h = (unsigned)chk_lo * 3u + (unsigned)(chk_lo >> 32) * 5u + (unsigned)chk_hi * 7u + (unsigned)(chk_hi >> 32) * 11u; }
#endif
        if (k < 3) SEL_LOAD(tn);
        if (fast) {
            int lane_s = lane; asm volatile("" : "+v"(lane_s));
            { unsigned z0 = 0u; asm volatile("" : "+v"(z0)); *(LAS u32x4*)(rowb + lane_s * 4) = u32x4{z0, z0, z0, z0}; }
            asm volatile("" ::: "memory");
            uint32_t ck[16], ci[16];
#pragma unroll
            for (int j = 0; j < 16; ++j) { const int p = j * 64 + lane_s; const uint32_t v = prl[p]; ck[j] = p < C ? okey(v) : 0u; ci[j] = pil[p]; }
            uint32_t mx = ck[0], mn = ck[0] ? ck[0] : 0xFFFFFFFFu;
#pragma unroll
            for (int j = 1; j < 16; ++j) { mx = ck[j] > mx ? ck[j] : mx; const uint32_t kz = ck[j] ? ck[j] : 0xFFFFFFFFu; mn = kz < mn ? kz : mn; }
            mx = wave_max_dpp(mx); mn = ~wave_max_dpp(~mn);
            const uint32_t dx = mn ^ mx;
            uint32_t prefix = mn; int hb = -1;
            if (dx != 0u) { hb = 31 - __builtin_clz(dx); prefix = (hb == 31) ? 0u : (mn & ~((2u << hb) - 1u)); }
            for (int bit = hb; bit >= 0; --bit) {
                const uint32_t cand = prefix | (1u << bit);
                int c0 = 0, c1 = 0, c2 = 0, c3 = 0;
                cnt4(c0, cand, ck[0], ck[1], ck[2], ck[3]); cnt4(c1, cand, ck[4], ck[5], ck[6], ck[7]); cnt4(c2, cand, ck[8], ck[9], ck[10], ck[11]); cnt4(c3, cand, ck[12], ck[13], ck[14], ck[15]);
                const int cnt = wave_sum_dpp((c0 + c1) + (c2 + c3));
                if (cnt >= TOPK) prefix = cand;
                if (cnt == TOPK) break;
            }
            const uint32_t T = prefix;
            int c_ge = 0, c_gt = 0;
#pragma unroll
            for (int j = 0; j < 16; ++j) { c_ge += (ck[j] >= T) ? 1 : 0; c_gt += (ck[j] > T) ? 1 : 0; }
            c_ge = wave_sum_dpp(c_ge);
            uint32_t Q = 0xFFFFFFFFu;
            if (c_ge != TOPK) {
                const int need = TOPK - wave_sum_dpp(c_gt);
                Q = 0u;
                for (int bit = 12; bit >= 0; --bit) {
                    const uint32_t cand = Q | (1u << bit);
                    int cl = 0;
#pragma unroll
                    for (int j = 0; j < 16; ++j) cl += (ck[j] == T && ci[j] < cand) ? 1 : 0;
                    if (wave_sum_dpp(cl) < need) Q = cand;
                }
            }
#pragma unroll
            for (int j = 0; j < 16; ++j) {
                const bool sel = (ck[j] > T) || (ck[j] == T && ci[j] <= Q);
                if (sel) __hip_atomic_fetch_or(rowb + (ci[j] >> 5), 1u << (ci[j] & 31), __ATOMIC_RELAXED, __HIP_MEMORY_SCOPE_WORKGROUP);
            }
            asm volatile("" ::: "memory");
            const LAS unsigned long long* rb64 = (const LAS unsigned long long*)rowb;
            const unsigned long long wlo_ = rb64[lane_s], whi_ = rb64[64 + lane_s];
#ifdef SEL_CHECK
            if (chk_h != (unsigned)wlo_ * 3u + (unsigned)(wlo_ >> 32) * 5u + (unsigned)whi_ * 7u + (unsigned)(whi_ >> 32) * 11u) poison[lane_s] = (f16)__builtin_nanf("");
#endif
            mrow[lane_s] = wlo_; mrow[64 + lane_s] = whi_;
        }
    }
}
#undef SEL_LOAD
#undef SEL_PIN
#undef PIN16K
constexpr int IDX_UNITS = 16512;
constexpr int IDX_QPITCH = 2320;
constexpr int IDX_TPITCH = 272;
constexpr int IDX_WOFF = 32 * IDX_QPITCH + 8 * 32 * IDX_TPITCH;
constexpr int IDX_LDS = IDX_WOFF + 2048;
__device__ __forceinline__ void idx_unit_decode(int u, int& strip, int& tile) {
    int m = (int)((sqrtf(4.0f * (float)u + 1.0f) - 1.0f) * 0.5f);
    while (m * (m + 1) > u) --m;
    while ((m + 1) * (m + 2) <= u) ++m;
    if (u < (m + 1) * (m + 1)) { strip = 2 * m; tile = u - m * (m + 1); } else { strip = 2 * m + 1; tile = u - (m + 1) * (m + 1); }
}
__device__ __forceinline__ float relu_asm(float x) { return __builtin_amdgcn_fmed3f(x, 0.f, __builtin_inff()); }
__device__ __forceinline__ void idx_phase(int blk, const f16* __restrict__ qi, const f16* __restrict__ ki, const float* __restrict__ wi, float* __restrict__ S, LAS unsigned char* lds, int w0) {
    const int tid = phase_tid(w0), wid = __builtin_amdgcn_readfirstlane(tid >> 6), lane = tid & 63, ql = lane & 31, kh = lane >> 5;
    LAS unsigned char* qs = lds;
    LAS unsigned char* tb = lds + 32 * IDX_QPITCH + wid * (32 * IDX_TPITCH);
    constexpr int IDX_ROUNDS = 2176;
    const int cu0 = blk <= 224 ? blk * 79 : 224 * 79 + (blk - 224) * 127, cu1 = (blk + 1) <= 224 ? (blk + 1) * 79 : 224 * 79 + (blk + 1 - 224) * 127;
    const int rlo = cu0 / 10, rhi = cu1 / 10;
    int rr = rlo;
    while (rr < rhi) {
        int q = (int)((sqrtf(0.5f * (float)rr + 1.0f) - 1.0f) * 0.5f);
        while (8 * q * (q + 1) > rr) --q;
        while (8 * (q + 1) * (q + 2) <= rr) ++q;
        const int rem = rr - 8 * q * (q + 1), strip = 16 * q + rem / (q + 1), j0 = rem % (q + 1);
        const int ntile = (strip >> 1) + 1;
        int jn = q + 1 - j0; if (jn > rhi - rr) jn = rhi - rr;
        const int tile0 = 8 * j0; int n = 8 * (j0 + jn); if (n > ntile) n = ntile; n -= tile0;
        const int sm = strip >> 1, u = ((strip & 1) ? (sm + 1) * (sm + 1) : sm * (sm + 1)) + tile0;
        const int t0 = strip * 32;
        __syncthreads();
#pragma unroll
        for (int i = 0; i < 8; ++i) { const int idx = tid + 512 * i, r = idx >> 7, c = (idx & 127) * 8;
            const u32x4 v = *(const u32x4*)(qi + (size_t)(t0 + r) * 1024 + c);
            *(LAS u32x4*)(qs + r * IDX_QPITCH + c * 2) = v; }
        if (tid < 128) { const int r = tid >> 2, c = (tid & 3) * 4; *(LAS f32x4*)(lds + IDX_WOFF + (r * 16 + c) * 4) = *(const f32x4*)(wi + (size_t)(t0 + r) * 16 + c); }
        __syncthreads();
        { const int r = tid >> 4, sg = (tid & 15) * 4; float a0 = 0.f, a1 = 0.f, a2 = 0.f, a3 = 0.f;
#pragma unroll
          for (int h = 0; h < 16; ++h) { const f16x4 q4 = *(const LAS f16x4*)(qs + r * IDX_QPITCH + (h * 64 + sg) * 2); const float wv = ((const LAS float*)(lds + IDX_WOFF))[r * 16 + h];
              a0 = fmaf((float)q4[0], wv, a0); a1 = fmaf((float)q4[1], wv, a1); a2 = fmaf((float)q4[2], wv, a2); a3 = fmaf((float)q4[3], wv, a3); }
          const f16 h0 = (f16)a0, h1 = (f16)a1, h2 = (f16)a2, h3 = (f16)a3;
          *(LAS f16x4*)(qs + r * IDX_QPITCH + 2048 + sg * 2) = (f16x4){h0, h1, h2, h3};
          *(LAS f16x4*)(qs + r * IDX_QPITCH + 2176 + sg * 2) = (f16x4){(f16)(a0 - (float)h0), (f16)(a1 - (float)h1), (f16)(a2 - (float)h2), (f16)(a3 - (float)h3)}; }
        __syncthreads();
        f16x8 kn[2][4];
#define IDX_LDK(dst, kbase) do { _Pragma("unroll") for (int kb = 0; kb < 2; ++kb) _Pragma("unroll") for (int kk = 0; kk < 4; ++kk) \
            dst[kb][kk] = *(const f16x8*)(ki + (size_t)((kbase) + kb * 32 + ql) * 64 + kk * 16 + kh * 8); } while (0)
        if (wid < n) IDX_LDK(kn, (tile0 + wid) * 64);
        for (int tl = wid; tl < n; tl += 8) {
            const int k0 = (tile0 + tl) * 64;
            f16x8 ka[2][4];
#pragma unroll
            for (int kb = 0; kb < 2; ++kb)
#pragma unroll
                for (int kk = 0; kk < 4; ++kk) ka[kb][kk] = kn[kb][kk];
            { const int tn = (tl + 8 < n) ? tl + 8 : tl; IDX_LDK(kn, (tile0 + tn) * 64); }
            f32x16 sc0 = {}, sc1 = {};
            const LAS unsigned char* qrow = qs + ql * IDX_QPITCH + kh * 16;
            const LAS float* wrow = (const LAS float*)(lds + IDX_WOFF) + ql * 16;
            f16x8 qbA[4], qbB[4];
#define IDX_LDQ(dst, off) do { _Pragma("unroll") for (int kk = 0; kk < 4; ++kk) dst[kk] = *(const LAS f16x8*)(qrow + (off) + kk * 32); } while (0)
#define IDX_HEAD(qb, D0, D1) do { D0 = f32x16{}; D1 = f32x16{}; \
                _Pragma("unroll") for (int kk = 0; kk < 4; ++kk) { D0 = __builtin_amdgcn_mfma_f32_32x32x16_f16(ka[0][kk], qb[kk], D0, 0, 0, 0); D1 = __builtin_amdgcn_mfma_f32_32x32x16_f16(ka[1][kk], qb[kk], D1, 0, 0, 0); } } while (0)
#define IDX_ACC(D0, D1, wh) do { _Pragma("unroll") for (int r = 0; r < 16; ++r) { float a0_ = fmaf(__builtin_fabsf(D0[r]), (wh), sc0[r]); asm("" : "+v"(a0_)); sc0[r] = a0_;     \
                float a1_ = fmaf(__builtin_fabsf(D1[r]), (wh), sc1[r]); asm("" : "+v"(a1_)); sc1[r] = a1_; } } while (0)
            f32x16 dA0, dA1, dB0, dB1;
            IDX_LDQ(qbA, 0);
            IDX_HEAD(qbA, dA0, dA1);
#pragma unroll 1
            for (int h = 0; h < 14; h += 2) {
                IDX_LDQ(qbB, (h + 1) * 128);
                { const float wh = wrow[h]; IDX_HEAD(qbB, dB0, dB1); IDX_ACC(dA0, dA1, wh); }
                __builtin_amdgcn_sched_barrier(0);
                IDX_LDQ(qbA, (h + 2) * 128);
                { const float wh = wrow[h + 1]; IDX_HEAD(qbA, dA0, dA1); IDX_ACC(dB0, dB1, wh); }
                __builtin_amdgcn_sched_barrier(0);
            }
            IDX_LDQ(qbB, 15 * 128);
            { const float wh = wrow[14]; IDX_HEAD(qbB, dB0, dB1); IDX_ACC(dA0, dA1, wh); }
            __builtin_amdgcn_sched_barrier(0);
            IDX_LDQ(qbA, 2048);
            { const float wh = wrow[15]; IDX_ACC(dB0, dB1, wh); }
            IDX_LDQ(qbB, 2048 + 128);
#pragma unroll
            for (int kk = 0; kk < 4; ++kk) { sc0 = __builtin_amdgcn_mfma_f32_32x32x16_f16(ka[0][kk], qbA[kk], sc0, 0, 0, 0); sc1 = __builtin_amdgcn_mfma_f32_32x32x16_f16(ka[1][kk], qbA[kk], sc1, 0, 0, 0); }
#pragma unroll
            for (int kk = 0; kk < 4; ++kk) { sc0 = __builtin_amdgcn_mfma_f32_32x32x16_f16(ka[0][kk], qbB[kk], sc0, 0, 0, 0); sc1 = __builtin_amdgcn_mfma_f32_32x32x16_f16(ka[1][kk], qbB[kk], sc1, 0, 0, 0); }
#undef IDX_LDQ
#undef IDX_HEAD
#undef IDX_ACC
#pragma unroll
            for (int g = 0; g < 4; ++g) {
                *(LAS f32x4*)(tb + ql * IDX_TPITCH + (8 * g + 4 * kh) * 4) = (f32x4){sc0[4 * g] * 0.015625f, sc0[4 * g + 1] * 0.015625f, sc0[4 * g + 2] * 0.015625f, sc0[4 * g + 3] * 0.015625f};
                *(LAS f32x4*)(tb + ql * IDX_TPITCH + (32 + 8 * g + 4 * kh) * 4) = (f32x4){sc1[4 * g] * 0.015625f, sc1[4 * g + 1] * 0.015625f, sc1[4 * g + 2] * 0.015625f, sc1[4 * g + 3] * 0.015625f};
            }
            asm volatile("s_waitcnt lgkmcnt(0)" ::: "memory");
#pragma unroll
            for (int i = 0; i < 8; ++i) { const int r = i * 4 + (lane >> 4), c = (lane & 15) * 4;
                const f32x4 v = *(const LAS f32x4*)(tb + r * IDX_TPITCH + c * 4);
                *(f32x4*)(S + (size_t)(u + tl) * 2048 + r * 64 + c) = v; }
            asm volatile("s_waitcnt lgkmcnt(0)" ::: "memory");
        }
#undef IDX_LDK
        rr += jn;
    }
}
namespace att {
constexpr int NW = 8, QBLK = 32, KVBLK = 64, QB = NW * QBLK;
constexpr int SHM_V = KVBLK * HD * 2, SHM_K = KVBLK * HD * 2;
constexpr int OFF_WS = 2 * SHM_V + 2 * SHM_K, OFF_DT = OFF_WS + NW * 64 * 4, OFF_V2 = OFF_DT + 1280, LDS_BYTES = OFF_V2 + SHM_V;
constexpr float SCALE = 0.08838834764831845f, THR = 8.f;
#define KSWZ(row, colB) ((row) * 256 + ((colB) ^ (((row) & 7) << 4)))
#define SBAR() __builtin_amdgcn_sched_barrier(0)
__device__ __forceinline__ int v_st(int k, int c) { const int kk = (k & ~0xC) | ((k & 4) << 1) | ((k & 8) >> 1); return ((kk >> 3) * 4 + (c >> 5)) * 512 + ((kk & 7) * 32 + (c & 31)) * 2; }
__device__ __forceinline__ int v_rd_base(int lane) { return ((lane & 3) << 3) | (((lane >> 2) & 3) << 6) | (((lane >> 4) & 1) << 5) | (((lane >> 5) & 1) << 8); }
constexpr int v_rd_off(int d0, int ks, int half) { return d0 * 512 + ks * 4096 + half * 2048; }
__device__ __forceinline__ int crow(int r, int hi) { return (r & 3) + 8 * (r >> 2) + 4 * hi; }
__device__ __forceinline__ __amdgpu_buffer_rsrc_t mkrsrc(const void* p, unsigned bytes) {
    const unsigned long long a = (unsigned long long)p; const unsigned lo = __builtin_amdgcn_readfirstlane((unsigned)a), hi = __builtin_amdgcn_readfirstlane((unsigned)(a >> 32));
    return __builtin_amdgcn_make_buffer_rsrc((void*)(((unsigned long long)hi << 32) | lo), (short)0, (int)bytes, 0x00020000); }
__device__ __forceinline__ f16x8 bld8(__amdgpu_buffer_rsrc_t r, unsigned voff, unsigned soff) { u32x4 v = __builtin_amdgcn_raw_buffer_load_b128(r, voff, soff, 0); return *reinterpret_cast<f16x8*>(&v); }
#define FMASK1(P, W, r, b) do { int m_; asm("v_bfe_i32 %0, %1, " #b ", 1" : "=v"(m_) : "v"(W)); P[r] = __uint_as_float(__float_as_uint(P[r]) & (unsigned)m_); } while (0)
#define FMASK16(P, W) do { FMASK1(P, W, 0, 0); FMASK1(P, W, 1, 1); FMASK1(P, W, 2, 2); FMASK1(P, W, 3, 3); FMASK1(P, W, 4, 8); FMASK1(P, W, 5, 9); FMASK1(P, W, 6, 10); FMASK1(P, W, 7, 11); \
    FMASK1(P, W, 8, 16); FMASK1(P, W, 9, 17); FMASK1(P, W, 10, 18); FMASK1(P, W, 11, 19); FMASK1(P, W, 12, 24); FMASK1(P, W, 13, 25); FMASK1(P, W, 14, 26); FMASK1(P, W, 15, 27); } while (0)
__device__ __forceinline__ void bias_tile(f32x16& p0, f32x16& p1, int dq, const float* dtab) {
    const float* bp = dtab + (dq + 96 - 59);
#pragma unroll
    for (int r = 0; r < 16; ++r) {
        const int c = (r & 3) + 8 * (r >> 2);
        p0[r] += bp[59 - c];
        p1[r] += bp[27 - c];
    }
}
__device__ __forceinline__ void partialSM(f32x16& p0, f32x16& p1, float& m_reg, float& mn, float& alpha, unsigned mlo) {
    float pmax = p0[0];
_Pragma("unroll") for (int r = 1; r < 16; ++r) pmax = fmaxf(pmax, p0[r]);
_Pragma("unroll") for (int r = 0; r < 16; ++r) pmax = fmaxf(pmax, p1[r]);
    { auto rr = __builtin_amdgcn_permlane32_swap(__float_as_uint(pmax), __float_as_uint(pmax), false, false);
      pmax = fmaxf(__uint_as_float(rr[0]), __uint_as_float(rr[1])); }
    constexpr float C2 = 1.4426950408889634f * SCALE;
    if (__builtin_expect(__all((pmax - m_reg) * SCALE <= THR), 1)) { mn = m_reg; alpha = 1.f; }
    else { mn = fmaxf(m_reg, pmax); alpha = __builtin_amdgcn_exp2f((m_reg - mn) * C2); m_reg = mn; }
    const float mnL = -mn * C2;
_Pragma("unroll") for (int r = 0; r < 16; ++r) p0[r] = fmaf(p0[r], C2, mnL);
_Pragma("unroll") for (int r = 0; r < 16; ++r) p1[r] = fmaf(p1[r], C2, mnL);
_Pragma("unroll") for (int r = 0; r < 16; ++r) p0[r] = __builtin_amdgcn_exp2f(p0[r]);
    FMASK16(p0, mlo);
}
__device__ __forceinline__ void finishSM(f32x16& p0, f32x16& p1, float alpha, float& l_reg, f16x8& pa0, f16x8& pa1, f16x8& pa2, f16x8& pa3, unsigned mhi) {
_Pragma("unroll") for (int r = 0; r < 16; ++r) p1[r] = __builtin_amdgcn_exp2f(p1[r]);
    FMASK16(p1, mhi);
    float ps = 0;
_Pragma("unroll") for (int r = 0; r < 16; ++r) ps += p0[r];
_Pragma("unroll") for (int r = 0; r < 16; ++r) ps += p1[r];
    { auto rr = __builtin_amdgcn_permlane32_swap(__float_as_uint(ps), __float_as_uint(ps), false, false);
      ps = __uint_as_float(rr[0]) + __uint_as_float(rr[1]); }
    l_reg = l_reg * alpha + ps;
#define PK4(P, B_, OUT) do { unsigned a0 = pack2(P[B_+0], P[B_+1]), a1 = pack2(P[B_+2], P[B_+3]);                          \
        unsigned b0 = pack2(P[B_+4], P[B_+5]), b1 = pack2(P[B_+6], P[B_+7]);                                             \
        auto r0 = __builtin_amdgcn_permlane32_swap(a0, b0, false, false); auto r1 = __builtin_amdgcn_permlane32_swap(a1, b1, false, false); \
        u32x4 w = {r0[0], r1[0], r0[1], r1[1]}; OUT = *reinterpret_cast<f16x8*>(&w); } while (0)
    PK4(p0, 0, pa0); PK4(p0, 8, pa1); PK4(p1, 0, pa2); PK4(p1, 8, pa3);
#undef PK4
}
template <int KB>
__device__ __forceinline__ void qkt(f32x16& p0, f32x16& p1, const char* K_lds, int r32, int hi, const f16x8* qr) {
    p0 = f32x16{}; p1 = f32x16{};
    const char* kb[4];
#pragma unroll
    for (int dd = 0; dd < 4; ++dd) kb[dd] = K_lds + KB * SHM_K + KSWZ(r32, (dd * 16 + hi * 8) * 2);
#pragma unroll
    for (int d0 = 0; d0 < 8; ++d0) { const char* a = kb[d0 & 3] + (d0 >> 2) * 128;
        f16x8 b0 = *reinterpret_cast<const f16x8*>(a);
        f16x8 b1 = *reinterpret_cast<const f16x8*>(a + 32 * 256);
        p0 = __builtin_amdgcn_mfma_f32_32x32x16_f16(b0, qr[d0], p0, 0, 0, 0);
        p1 = __builtin_amdgcn_mfma_f32_32x32x16_f16(b1, qr[d0], p1, 0, 0, 0); }
}
template <int VB>
__device__ __forceinline__ void pv_tile(f32x16* o, int vb0, f16x8 pa0, f16x8 pa1, f16x8 pa2, f16x8 pa3) {
    typedef _Float16 h4 __attribute__((ext_vector_type(4)));
#define TRRD(dst, off) asm volatile("ds_read_b64_tr_b16 %0, %1 offset:%2" : "=&v"(dst) : "v"(vb0), "i"(off) : "memory")
#define PV_D0(d0) do { h4 l0, l1, l2, l3, h0, h1, h2, h3; constexpr int b_ = v_rd_off(d0, 0, 0); \
        TRRD(l0, b_); TRRD(h0, b_ + 2048); TRRD(l1, b_ + 4096); TRRD(h1, b_ + 6144); TRRD(l2, b_ + 8192); TRRD(h2, b_ + 10240); TRRD(l3, b_ + 12288); TRRD(h3, b_ + 14336); \
        asm volatile("s_waitcnt lgkmcnt(0)" ::: "memory"); SBAR();   \
        o[d0] = __builtin_amdgcn_mfma_f32_32x32x16_f16(pa0, (f16x8){l0[0], l0[1], l0[2], l0[3], h0[0], h0[1], h0[2], h0[3]}, o[d0], 0, 0, 0);   \
        o[d0] = __builtin_amdgcn_mfma_f32_32x32x16_f16(pa1, (f16x8){l1[0], l1[1], l1[2], l1[3], h1[0], h1[1], h1[2], h1[3]}, o[d0], 0, 0, 0);   \
        o[d0] = __builtin_amdgcn_mfma_f32_32x32x16_f16(pa2, (f16x8){l2[0], l2[1], l2[2], l2[3], h2[0], h2[1], h2[2], h2[3]}, o[d0], 0, 0, 0);   \
        o[d0] = __builtin_amdgcn_mfma_f32_32x32x16_f16(pa3, (f16x8){l3[0], l3[1], l3[2], l3[3], h3[0], h3[1], h3[2], h3[3]}, o[d0], 0, 0, 0); } while (0)
    PV_D0(0); PV_D0(1); PV_D0(2); PV_D0(3);
#undef PV_D0
#undef TRRD
}
struct BlockRef { const f16* Q; const f16* K; const f16* V; f16* O; float* ML; const unsigned long long* M; int P0, j_lo, j_hi, pad; };
struct Seam { f16x8 qr[8]; f16x8 st_v0, st_v1, st_k0, st_k1; };
#define VMW() asm volatile("s_waitcnt vmcnt(0)" ::: "memory")
#define VMWN(n) asm volatile("s_waitcnt vmcnt(%0)" :: "i"(n) : "memory")
#define SLOAD_H(rK, rV, k0) do { const unsigned so_ = (unsigned)(k0) * (HD * 2);     \
                         S.st_v0 = bld8(rV, kvoff, so_); S.st_v1 = bld8(rV, kvoff + 32 * HD * 2, so_);              \
                         S.st_k0 = bld8(rK, kvoff, so_); S.st_k1 = bld8(rK, kvoff + 32 * HD * 2, so_); } while (0)
#define SWRITE_HK(bf) do { *(f16x8*)(K_lds + (bf) * SHM_K + kws) = S.st_k0; *(f16x8*)(K_lds + (bf) * SHM_K + kws + 32 * 256) = S.st_k1; } while (0)
#define SWRITE_HV(bf) do { *(f16x8*)(V_lds + (bf) * SHM_V + vst0) = S.st_v0; *(f16x8*)(V_lds + (bf) * SHM_V + vst1) = S.st_v1; } while (0)
#define SWRITE_HVO(off) do { *(f16x8*)(V_lds + (off) + vst0) = S.st_v0; *(f16x8*)(V_lds + (off) + vst1) = S.st_v1; } while (0)
#define SWRITE_H(bf) do { SWRITE_HV(bf); SWRITE_HK(bf); } while (0)
__device__ __forceinline__ void att_prime(const BlockRef& cur, char* lds, Seam& S, int tid_) {
    const int tid = tid_, wid = __builtin_amdgcn_readfirstlane(tid >> 6), lane = tid & 63, r32 = lane & 31, hi = lane >> 5;
    const int sr = tid >> 4, sc = (tid & 15) * 8, kws = KSWZ(sr, sc * 2); char* K_lds = lds + 2 * SHM_V;
    const unsigned kvoff = (unsigned)((sr * HD + sc) * 2), qoff = (unsigned)((r32 * HD + hi * 8) * 2);
    const int kb0 = cur.j_lo * KVBLK;
    { const __amdgpu_buffer_rsrc_t rQ = mkrsrc(cur.Q, QB * HD * 2);
  _Pragma("unroll") for (int d0 = 0; d0 < 8; ++d0) S.qr[d0] = bld8(rQ, qoff + d0 * 32, (unsigned)(wid * QBLK * HD * 2)); }
    { const __amdgpu_buffer_rsrc_t rK = mkrsrc(cur.K, L * HD * 2), rV = mkrsrc(cur.V, L * HD * 2);
      SLOAD_H(rK, rV, kb0); } VMW(); SWRITE_HK(0);
    __syncthreads();
}
__device__ __forceinline__ void att_block(const BlockRef& cur, const BlockRef& nxt, char* lds, Seam& S, int tid_) {
    const int tid = tid_, wid = __builtin_amdgcn_readfirstlane(tid >> 6), lane = tid & 63, r32 = lane & 31, hi = lane >> 5;
    const int j_lo = cur.j_lo, NT = cur.j_hi - cur.j_lo;
    const int kbn = nxt.j_lo * KVBLK;
    const int qlo = cur.P0 + wid * QBLK;
    char* V_lds = lds; char* K_lds = lds + 2 * SHM_V;
    float* ws = (float*)(lds + OFF_WS) + wid * 64; float* li_l = ws, * al_l = ws + 32;
    const float* dtab = (const float*)(lds + OFF_DT);
    float m_reg = -1e30f, l_reg = 0; f32x16 o[4] = {};
    const int sr = tid >> 4, sc = (tid & 15) * 8, vst0 = v_st(sr, sc), vst1 = v_st(32 + sr, sc), kws = KSWZ(sr, sc * 2);
    const unsigned kvoff = (unsigned)((sr * HD + sc) * 2), qoff = (unsigned)((r32 * HD + hi * 8) * 2);
    const int vb0 = (int)(uintptr_t)V_lds + v_rd_base(lane);
    const __amdgpu_buffer_rsrc_t Kh = mkrsrc(cur.K, L * HD * 2), Vh = mkrsrc(cur.V, L * HD * 2);
    const __amdgpu_buffer_rsrc_t rM = mkrsrc((const char*)cur.M + (size_t)qlo * 1024, 32 * 1024);
    const unsigned moff = (unsigned)r32 * 1024u;
#define MWLO(t) (__builtin_amdgcn_raw_buffer_load_b32(rM, moff, (unsigned)(j_lo + (t)) * 8u, 0) >> sh4)
#define MWHI(t) (__builtin_amdgcn_raw_buffer_load_b32(rM, moff + 4u, (unsigned)(j_lo + (t)) * 8u, 0) >> sh4)
    const int sh4 = 4 * hi;
#define RESC(a) do { if (__any((a) < 1.f)) { int ln_; asm volatile("v_mbcnt_lo_u32_b32 %0, -1, 0\n\tv_mbcnt_hi_u32_b32 %0, -1, %0" : "=v"(ln_));     \
                     if ((ln_ >> 5) == 0) al_l[ln_ & 31] = (a); asm volatile("s_waitcnt lgkmcnt(0)" ::: "memory");              \
                     const float* alh_ = al_l + 4 * (ln_ >> 5);                                                                       \
                     _Pragma("unroll") for (int d_ = 0; d_ < 4; ++d_) _Pragma("unroll") for (int r = 0; r < 16; ++r) o[d_][r] *= alh_[crow(r, 0)]; } } while (0)
#define KBASE(t) ((j_lo + (t)) * KVBLK)
#define BIAST(P0_, P1_, t) do { const int kb_ = KBASE(t); if (kb_ > qlo - 176 && kb_ <= qlo + QBLK - 1) { int ln_;     \
        asm volatile("v_mbcnt_lo_u32_b32 %0, -1, 0\n\tv_mbcnt_hi_u32_b32 %0, -1, %0" : "=v"(ln_)); bias_tile(P0_, P1_, qlo + (ln_ & 31) - 4 * (ln_ >> 5) - kb_, dtab); } } while (0)
    constexpr int NQL = 8;
#define SEAM_K0() do { VMWN(NQL); SWRITE_HK(0); SBAR(); } while (0)
    f32x16 pA0, pA1, pB0, pB1; float mnA, mnB, alA, alB; f16x8 pa0, pa1, pa2, pa3;
    unsigned mlA, mlB = 0u, mhA, mhB = 0u;
    SWRITE_HV(0); SBAR();
    mlA = MWLO(0);
    if (NT > 1) { SLOAD_H(Kh, Vh, KBASE(1)); }
    SBAR(); qkt<0>(pA0, pA1, K_lds, r32, hi, S.qr);
    BIAST(pA0, pA1, 0); partialSM(pA0, pA1, m_reg, mnA, alA, mlA); mhA = MWHI(0);
    if (NT > 1) { VMWN(1); SWRITE_H(1); }
    __syncthreads();
    int vr = 0, vm = SHM_V, vw = OFF_V2;
#define HALF_STEP(PX0, PX1, mnX, alX, mlX, mhX, PY0, PY1, alY, mhY, t, KB, SB) do {                                         \
        mlX = MWLO(t);                                                                                                        \
        SBAR(); qkt<KB>(PX0, PX1, K_lds, r32, hi, S.qr);                                                                      \
        finishSM(PY0, PY1, alY, l_reg, pa0, pa1, pa2, pa3, mhY); SBAR();                                                      \
        if ((t) + 1 < NT) { SLOAD_H(Kh, Vh, KBASE((t) + 1)); SBAR(); }                                                        \
        pv_tile<0>(o, vb0 + vr, pa0, pa1, pa2, pa3); BIAST(PX0, PX1, (t)); partialSM(PX0, PX1, m_reg, mnX, alX, mlX);         \
        mhX = MWHI(t);                                                                                                        \
        if ((t) + 1 < NT) { VMWN(1); SWRITE_HK(SB); SWRITE_HVO(vw); }               \
        RESC(alX); __syncthreads();                                                                                           \
        { const int t_ = vr; vr = vm; vm = vw; vw = t_; } } while (0)
    for (int t = 1; t + 1 < NT; t += 2) {
        HALF_STEP(pB0, pB1, mnB, alB, mlB, mhB, pA0, pA1, alA, mhA, t, 1, 0);
        HALF_STEP(pA0, pA1, mnA, alA, mlA, mhA, pB0, pB1, alB, mhB, t + 1, 0, 1);
    }
    const bool even = (NT & 1) == 0;
    if (even) { mlB = MWLO(NT - 1); mhB = MWHI(NT - 1); SBAR(); qkt<1>(pB0, pB1, K_lds, r32, hi, S.qr); SBAR(); }
    { const __amdgpu_buffer_rsrc_t rKn = mkrsrc(nxt.K, L * HD * 2), rVn = mkrsrc(nxt.V, L * HD * 2);
      SLOAD_H(rKn, rVn, kbn); } SBAR();
    { const __amdgpu_buffer_rsrc_t rQ = mkrsrc(nxt.Q, QB * HD * 2);
#pragma unroll
      for (int d0 = 0; d0 < 8; ++d0) S.qr[d0] = bld8(rQ, qoff + d0 * 32, (unsigned)(wid * QBLK * HD * 2)); }
    SBAR();
    finishSM(pA0, pA1, alA, l_reg, pa0, pa1, pa2, pa3, mhA); SBAR();
    pv_tile<0>(o, vb0 + vr, pa0, pa1, pa2, pa3);
    if (even) { BIAST(pB0, pB1, NT - 1); partialSM(pB0, pB1, m_reg, mnB, alB, mlB); __syncthreads(); RESC(alB);
        finishSM(pB0, pB1, alB, l_reg, pa0, pa1, pa2, pa3, mhB); SBAR(); pv_tile<0>(o, vb0 + vm, pa0, pa1, pa2, pa3); }
    SBAR(); SEAM_K0();
    int lane_e; asm volatile("v_mbcnt_lo_u32_b32 %0, -1, 0\n\tv_mbcnt_hi_u32_b32 %0, -1, %0" : "=v"(lane_e));
    const int r32e = lane_e & 31, hie = lane_e >> 5;
    if (hie == 0) li_l[r32e] = l_reg; asm volatile("s_waitcnt lgkmcnt(0)" ::: "memory");
    f16* Ow = cur.O + (size_t)(wid * QBLK) * HD + r32e;
#pragma unroll
    for (int r = 0; r < 16; ++r) { const int orow = crow(r, hie); const float lr = li_l[orow]; const float rl = lr > 0.f ? __builtin_amdgcn_rcpf(lr) : 0.f;
#pragma unroll
        for (int d0 = 0; d0 < 4; ++d0) { const float v = o[d0][r] * rl; const float vn = swz_xor<1>(v);
            if ((r32e & 1) == 0) *(unsigned*)(Ow + (size_t)orow * HD + d0 * 32) = pack2(v, vn); } }
    if (hie == 0) { float* mlp = cur.ML + (size_t)(wid * QBLK + r32e) * 2; mlp[0] = m_reg; mlp[1] = l_reg; }
    __syncthreads();
#undef RESC
#undef MWLO
#undef MWHI
#undef KBASE
#undef BIAST
#undef SEAM_K0
#undef HALF_STEP
}
#undef VMW
#undef VMWN
#undef SLOAD_H
#undef SWRITE_HK
#undef SWRITE_HV
#undef SWRITE_H
}

__device__ __forceinline__ int t5_bucket(int rel) {
    if (rel < 0) rel = 0;
    if (rel < 16) return rel;
    const float relf = (float)rel;
    int large = 16 + (int)(logf(relf / 16.0f) / 2.0794415416798357f * 16.0f);
    return large < 31 ? large : 31;
}
__device__ __forceinline__ void attn_phase(int blk, const f16* __restrict__ qkv, const unsigned long long* __restrict__ mask, const float* __restrict__ rel_bias, f16* __restrict__ Opart, float* __restrict__ ML, char* lds, int w0) {
    const int h = blk & 7, rem = blk >> 3, p = rem >> 1, half = rem & 1;
    __syncthreads();
    const int tid_ = phase_tid(w0);
    if (tid_ < 320) { const int rel = tid_ - 96; float v = 0.f;
        if (rel >= 0 && rel < 113) v = (rel_bias[t5_bucket(rel) * NH + h] - rel_bias[31 * NH + h]) * (1.0f / att::SCALE);
        ((float*)(lds + att::OFF_DT))[tid_] = v; }
    const float* Qh = (const float*)nullptr; (void)Qh;
    auto mk = [&](int x) { att::BlockRef r; const int nt2 = 2 * (x + 1);
        r.Q = qkv + ((size_t)h * L + (size_t)x * 256) * HD; r.K = qkv + (size_t)(8 + h) * L * HD; r.V = qkv + (size_t)(16 + h) * L * HD;
        r.O = Opart + (((size_t)half * NH + h) * L + (size_t)x * 256) * HD; r.ML = ML + (((size_t)half * NH + h) * L + (size_t)x * 256) * 2;
        r.M = mask; r.P0 = x * 256; r.j_lo = half * nt2; r.j_hi = (half + 1) * nt2; r.pad = 0; return r; };
    att::BlockRef cur = mk(p); const att::BlockRef last = mk(31 - p);
    att::Seam S;
    att::att_prime(cur, lds, S, tid_);
    for (int pass = 0; pass < 2; ++pass) {
        att::att_block(cur, last, lds, S, tid_);
        cur = last;
    }
}
#define PIN16(a, b) asm volatile("" : "+v"(a[(b)+0]), "+v"(a[(b)+1]), "+v"(a[(b)+2]), "+v"(a[(b)+3]), "+v"(a[(b)+4]), "+v"(a[(b)+5]), "+v"(a[(b)+6]), "+v"(a[(b)+7]), \
                                    "+v"(a[(b)+8]), "+v"(a[(b)+9]), "+v"(a[(b)+10]), "+v"(a[(b)+11]), "+v"(a[(b)+12]), "+v"(a[(b)+13]), "+v"(a[(b)+14]), "+v"(a[(b)+15]))
constexpr int LOC_AP = 1040;
constexpr int LOC_BP = 516;
constexpr int LOC_D16 = 0, LOC_X16 = 32 * LOC_AP, LOC_BUF = 2 * 32 * LOC_AP, LOC_LDS = LOC_BUF + 32 * LOC_BP * 4;
struct LocParams { const f16* pl; const f16* poolWt; const f16* rWt; const f16* iWt; const float* pool_scale; const float* g_pool; const float* conv_w; const float* conv_b;
                   const float* r_b; const float* i_b; const float* lam; float* hloc; float* Pp; float* Acar; float* Hcar; f16* mixed16; int m8, pad; };
template <int WIN> __device__ __forceinline__ void pool_d(const float (&u)[48], int t0, int c, LAS unsigned char* lds) {
#pragma unroll
    for (int t = 0; t < 32; ++t) { float s = 0.f;
#pragma unroll
        for (int j = 0; j < WIN; ++j) s += u[t + 15 - j];
        const int cnt = (t0 + t + 1) < WIN ? (t0 + t + 1) : WIN;
        *(LAS f16*)(lds + LOC_D16 + t * LOC_AP + c * 2) = (f16)(s / (float)cnt - u[t + 15]); }
}
__device__ __forceinline__ void loc_mm(LAS unsigned char* lds, int aoff, const f16* __restrict__ Wt, int g, int cb, int lane) {
    const int i = lane & 31, kh = lane >> 5;
    f32x16 d = {};
    const f16* wp = Wt + ((size_t)(g * 128 + cb * 32 + i) * 128 + kh * 8);
#pragma unroll
    for (int kk = 0; kk < 8; ++kk) {
        const f16x8 a = *(const LAS f16x8*)(lds + aoff + i * LOC_AP + (g * 128 + kk * 16 + kh * 8) * 2);
        const f16x8 b = *(const f16x8*)(wp + kk * 16);
        d = __builtin_amdgcn_mfma_f32_32x32x16_f16(a, b, d, 0, 0, 0);
    }
    LAS float* buf = (LAS float*)(lds + LOC_BUF);
#pragma unroll
    for (int r = 0; r < 16; ++r) buf[((r & 3) + 8 * (r >> 2) + 4 * kh) * LOC_BP + g * 128 + cb * 32 + i] = d[r];
}
__device__ __forceinline__ void local_phase(int chunk, const LocParams& p, LAS unsigned char* lds, int w0) {
    const int c = phase_tid(w0), lane = c & 63, wid = __builtin_amdgcn_readfirstlane(c >> 6), g = wid >> 1, t0 = chunk * 32;
    LAS float* buf = (LAS float*)(lds + LOC_BUF);
    __syncthreads();
    {
        float u[48];
#pragma unroll
        for (int j = 0; j < 48; ++j) { const int tt = t0 - 15 + j; u[j] = (float)p.pl[(size_t)(tt > 0 ? tt : 0) * 1536 + c]; }
        PIN16(u, 0); PIN16(u, 16); PIN16(u, 32);
#pragma unroll
        for (int j = 0; j < 15; ++j) u[j] = (t0 - 15 + j) >= 0 ? u[j] : 0.f;
        if (g == 0) pool_d<2>(u, t0, c, lds); else if (g == 1) pool_d<4>(u, t0, c, lds); else if (g == 2) pool_d<8>(u, t0, c, lds); else pool_d<16>(u, t0, c, lds);
    }
    float xc[32];
    {
        float v[48];
#pragma unroll
        for (int j = 0; j < 48; ++j) { int tt = t0 - 3 + j; tt = tt > 0 ? tt : 0; tt = tt < L ? tt : L - 1; v[j] = j < 35 ? (float)p.pl[(size_t)tt * 1536 + 512 + c] : 0.f; }
        PIN16(v, 0); PIN16(v, 16); PIN16(v, 32);
#pragma unroll
        for (int j = 0; j < 3; ++j) v[j] = (t0 - 3 + j) >= 0 ? v[j] : 0.f;
        const float w0 = p.conv_w[c], w1 = p.conv_w[LW + c], w2 = p.conv_w[2 * LW + c], w3 = p.conv_w[3 * LW + c], cb = p.conv_b[c];
#pragma unroll
        for (int t = 0; t < 32; ++t) { xc[t] = cb + w0 * v[t] + w1 * v[t + 1] + w2 * v[t + 2] + w3 * v[t + 3];
            *(LAS f16*)(lds + LOC_X16 + t * LOC_AP + c * 2) = (f16)xc[t]; }
    }
    __syncthreads();
    loc_mm(lds, LOC_X16, p.rWt, g, (wid & 1) * 2, lane); loc_mm(lds, LOC_X16, p.rWt, g, (wid & 1) * 2 + 1, lane);
    __syncthreads();
    float la[32];
    { const float rb = p.r_b[c], sp = log1pf(expf(-p.lam[c]));
#pragma unroll
      for (int t = 0; t < 32; ++t) { const float r = __builtin_amdgcn_rcpf(1.0f + __expf(-(buf[t * LOC_BP + c] + rb))); la[t] = -8.0f * r * sp; } }
    __syncthreads();
    loc_mm(lds, LOC_X16, p.iWt, g, (wid & 1) * 2, lane); loc_mm(lds, LOC_X16, p.iWt, g, (wid & 1) * 2 + 1, lane);
    __syncthreads();
    { const float ib = p.i_b[c]; float h = 0.f, P = 1.f;
#pragma unroll
      for (int t = 0; t < 32; ++t) { const float ig = __builtin_amdgcn_rcpf(1.0f + __expf(-(buf[t * LOC_BP + c] + ib)));
          const float x2 = 2.0f * la[t], a = __expf(la[t]);
          const float om = (x2 > -0.25f) ? -x2 * (1.0f + x2 * (0.5f + x2 * (0.16666667f + x2 * (0.041666668f + x2 * 0.0083333338f)))) : 1.0f - a * a;
          const float b = __builtin_amdgcn_sqrtf(om) * (ig * xc[t]);
          h = a * h + b; P *= a;
          p.hloc[(size_t)(t0 + t) * LW + c] = h; p.Pp[(size_t)(t0 + t) * LW + c] = P; }
      p.Acar[(size_t)chunk * LW + c] = P; p.Hcar[(size_t)chunk * LW + c] = h; }
    __syncthreads();
    loc_mm(lds, LOC_D16, p.poolWt, g, (wid & 1) * 2, lane); loc_mm(lds, LOC_D16, p.poolWt, g, (wid & 1) * 2 + 1, lane);
    __syncthreads();
    { const int t = c >> 4, seg = c & 15; float y[32]; float ss = 0.f;
#pragma unroll
      for (int j2 = 0; j2 < 16; ++j2) { const int co = 2 * (16 * j2 + seg); typedef float f32x2l __attribute__((ext_vector_type(2))); const f32x2l v2 = *(const LAS f32x2l*)(buf + t * LOC_BP + co);
          y[2 * j2] = v2[0] * p.pool_scale[co]; y[2 * j2 + 1] = v2[1] * p.pool_scale[co + 1]; ss += y[2 * j2] * y[2 * j2] + y[2 * j2 + 1] * y[2 * j2 + 1]; }
      ss += swz_xor<1>(ss); ss += swz_xor<2>(ss); ss += swz_xor<4>(ss); ss += swz_xor<8>(ss);
      const float rs = rsqrtf(ss * (1.0f / PW) + EPS);
      if (p.m8) { unsigned char* mp8 = (unsigned char*)p.mixed16 + (size_t)(t0 + t) * D + AW;
#pragma unroll
          for (int j2 = 0; j2 < 16; ++j2) { const int co = 2 * (16 * j2 + seg);
              *(unsigned short*)(mp8 + co) = (unsigned short)__builtin_amdgcn_cvt_pk_fp8_f32(y[2 * j2] * rs * p.g_pool[co], y[2 * j2 + 1] * rs * p.g_pool[co + 1], 0u, false); } }
      else { f16* mp = p.mixed16 + (size_t)(t0 + t) * D + AW;
#pragma unroll
          for (int j2 = 0; j2 < 16; ++j2) { const int co = 2 * (16 * j2 + seg);
              *(unsigned*)(mp + co) = pack2(y[2 * j2] * rs * p.g_pool[co], y[2 * j2 + 1] * rs * p.g_pool[co + 1]); } } }
    __syncthreads();
}
__device__ __forceinline__ void carry_phase(int grp, const float* __restrict__ Acar, const float* __restrict__ Hcar, float* __restrict__ Apre, float* __restrict__ Hpre, float* __restrict__ AG, float* __restrict__ HG, int w0) {
    const int c = phase_tid(w0); float A = 1.f, H = 0.f;
#pragma unroll
    for (int k = 0; k < 16; ++k) { const size_t o = (size_t)(grp * 16 + k) * LW + c; Apre[o] = A; Hpre[o] = H; const float a = Acar[o], h = Hcar[o]; H = a * H + h; A = a * A; }
    AG[(size_t)grp * LW + c] = A; HG[(size_t)grp * LW + c] = H;
}
__device__ __forceinline__ float gelu_tanh_f(float x) { const float u = 0.7978845608028654f * (x + 0.044715f * x * x * x); const float e = __expf(2.0f * u); return 0.5f * x * (1.0f + (1.0f - 2.0f / (e + 1.0f))); }
struct MixParams { const f16* Opart; const float* ML; const float* hloc; const float* Pp; const float* Apre; const float* Hpre; const float* AG; const float* HG; const f16* pl;
                   const float* g_attn; const float* g_lru; f16* mixed16; int m8, pad; };
__device__ __forceinline__ void mix_phase(int blk, const MixParams& p, LAS unsigned char* lds, int w0) {
    const int tid = phase_tid(w0), lane = tid & 63, wv = blk * 8 + __builtin_amdgcn_readfirstlane(tid >> 6);
    LAS float* Gin = (LAS float*)lds;
    __syncthreads();
    { float av[15], hv[15];
#pragma unroll
      for (int v = 0; v < 15; ++v) { av[v] = p.AG[(size_t)v * LW + tid]; hv[v] = p.HG[(size_t)v * LW + tid]; }
      float hcur = 0.f; Gin[tid] = 0.f;
#pragma unroll
      for (int v = 0; v < 15; ++v) { hcur = av[v] * hcur + hv[v]; Gin[(v + 1) * LW + tid] = hcur; } }
    __syncthreads();
    constexpr float C2 = 1.4426950408889634f * 0.08838834764831845f;
    for (int t = wv; t < L; t += NBLK * 8) {
        const int h = lane >> 3, d0 = (lane & 7) * 16;
        const size_t r0 = ((size_t)0 * NH + h) * L + t, r1 = ((size_t)1 * NH + h) * L + t;
        const float m0 = p.ML[r0 * 2], l0 = p.ML[r0 * 2 + 1], m1 = p.ML[r1 * 2], l1 = p.ML[r1 * 2 + 1];
        const float m = fmaxf(m0, m1), a0 = l0 * exp2f((m0 - m) * C2), a1 = l1 * exp2f((m1 - m) * C2), inv = 1.0f / (a0 + a1), cw0 = a0 * inv, cw1 = a1 * inv;
        f32x4 o[4]; float ss = 0.f;
#pragma unroll
        for (int q = 0; q < 4; q += 2) { const f16x8 x0 = *(const f16x8*)(p.Opart + r0 * HD + d0 + q * 4), x1 = *(const f16x8*)(p.Opart + r1 * HD + d0 + q * 4);
#pragma unroll
            for (int j = 0; j < 4; ++j) { o[q][j] = (float)x0[j] * cw0 + (float)x1[j] * cw1; o[q + 1][j] = (float)x0[4 + j] * cw0 + (float)x1[4 + j] * cw1; }
            ss += o[q][0] * o[q][0] + o[q][1] * o[q][1] + o[q][2] * o[q][2] + o[q][3] * o[q][3] + o[q + 1][0] * o[q + 1][0] + o[q + 1][1] * o[q + 1][1] + o[q + 1][2] * o[q + 1][2] + o[q + 1][3] * o[q + 1][3]; }
        ss = wave_sum(ss);
        const float ra = rsqrtf(ss * (1.0f / AW) + EPS);
        f16* mr = p.mixed16 + (size_t)t * D;
#pragma unroll
        for (int q = 0; q < 4; q += 2) { const int col = h * HD + d0 + q * 4; const f32x4 g0 = *(const f32x4*)(p.g_attn + col), g1 = *(const f32x4*)(p.g_attn + col + 4);
            const f32x4 y0 = o[q] * ra * g0, y1 = o[q + 1] * ra * g1;
            if (p.m8) { unsigned w0_ = 0u, w1_ = 0u; w0_ = __builtin_amdgcn_cvt_pk_fp8_f32(y0[0], y0[1], w0_, false); w0_ = __builtin_amdgcn_cvt_pk_fp8_f32(y0[2], y0[3], w0_, true);
                w1_ = __builtin_amdgcn_cvt_pk_fp8_f32(y1[0], y1[1], w1_, false); w1_ = __builtin_amdgcn_cvt_pk_fp8_f32(y1[2], y1[3], w1_, true);
                *(u32x2*)((unsigned char*)p.mixed16 + (size_t)t * D + col) = (u32x2){w0_, w1_}; }
            else *(u32x4*)(mr + col) = (u32x4){pack2(y0[0], y0[1]), pack2(y0[2], y0[3]), pack2(y1[0], y1[1]), pack2(y1[2], y1[3])}; }
        const int c0 = lane * 8, chunk = t >> 5, grp = chunk >> 4;
        float hin[8];
        { const f32x4 g0_ = *(const LAS f32x4*)(Gin + grp * LW + c0), g1_ = *(const LAS f32x4*)(Gin + grp * LW + c0 + 4);
#pragma unroll
          for (int j = 0; j < 4; ++j) { hin[j] = g0_[j]; hin[4 + j] = g1_[j]; } }
        float lo[8]; float sl = 0.f;
        {
            const size_t oc = (size_t)chunk * LW + c0, ot = (size_t)t * LW + c0;
            const f32x4 ap0 = *(const f32x4*)(p.Apre + oc), ap1 = *(const f32x4*)(p.Apre + oc + 4), hp0 = *(const f32x4*)(p.Hpre + oc), hp1 = *(const f32x4*)(p.Hpre + oc + 4);
            const f32x4 hl0 = *(const f32x4*)(p.hloc + ot), hl1 = *(const f32x4*)(p.hloc + ot + 4), pp0 = *(const f32x4*)(p.Pp + ot), pp1 = *(const f32x4*)(p.Pp + ot + 4);
            const f16x8 gth = *(const f16x8*)(p.pl + (size_t)t * 1536 + 1024 + c0);
            const f32x4 gt0 = {(float)gth[0], (float)gth[1], (float)gth[2], (float)gth[3]}, gt1 = {(float)gth[4], (float)gth[5], (float)gth[6], (float)gth[7]};
#pragma unroll
            for (int j = 0; j < 4; ++j) {
                const float hc0 = ap0[j] * hin[j] + hp0[j], hc1 = ap1[j] * hin[4 + j] + hp1[j];
                lo[j] = (hl0[j] + pp0[j] * hc0) * gelu_tanh_f(gt0[j]); lo[4 + j] = (hl1[j] + pp1[j] * hc1) * gelu_tanh_f(gt1[j]);
                sl += lo[j] * lo[j] + lo[4 + j] * lo[4 + j]; }
        }
        sl = wave_sum(sl);
        const float rl = rsqrtf(sl * (1.0f / LW) + EPS);
        { const f32x4 g0 = *(const f32x4*)(p.g_lru + c0), g1 = *(const f32x4*)(p.g_lru + c0 + 4);
          if (p.m8) { unsigned w0_ = 0u, w1_ = 0u; w0_ = __builtin_amdgcn_cvt_pk_fp8_f32(lo[0] * rl * g0[0], lo[1] * rl * g0[1], w0_, false); w0_ = __builtin_amdgcn_cvt_pk_fp8_f32(lo[2] * rl * g0[2], lo[3] * rl * g0[3], w0_, true);
              w1_ = __builtin_amdgcn_cvt_pk_fp8_f32(lo[4] * rl * g1[0], lo[5] * rl * g1[1], w1_, false); w1_ = __builtin_amdgcn_cvt_pk_fp8_f32(lo[6] * rl * g1[2], lo[7] * rl * g1[3], w1_, true);
              *(u32x2*)((unsigned char*)p.mixed16 + (size_t)t * D + AW + PW + c0) = (u32x2){w0_, w1_}; }
          else           *(u32x4*)(mr + AW + PW + c0) = (u32x4){pack2(lo[0] * rl * g0[0], lo[1] * rl * g0[1]), pack2(lo[2] * rl * g0[2], lo[3] * rl * g0[3]),
                                                pack2(lo[4] * rl * g1[0], lo[5] * rl * g1[1]), pack2(lo[6] * rl * g1[2], lo[7] * rl * g1[3])}; }
    }
}
#define XB_TMO      128
#define XB_XCNT(j)  (256  + 64 * (j))
#define XB_XSUB(j)  (1280 + 64 * (j))
#define XB_XGEN(j)  (2304 + 64 * (j))
#define XB_TOP      3328
#define XB_TOPGEN   3392
#define XCD_BAR_WORDS 3456
#define XB_SPIN_CAP (1u << 18)

__device__ __forceinline__ unsigned xb_ld(unsigned* p)              { return __hip_atomic_load(p, __ATOMIC_RELAXED, __HIP_MEMORY_SCOPE_AGENT); }
__device__ __forceinline__ unsigned xb_add(unsigned* p, unsigned v) { return __hip_atomic_fetch_add(p, v, __ATOMIC_RELAXED, __HIP_MEMORY_SCOPE_AGENT); }
__device__ __forceinline__ unsigned xb_xcc_id() { return (unsigned)__builtin_amdgcn_s_getreg((3 << 11) | 20) & 0xFu; }
#define XB_SPIN(cond, bar) do { unsigned _sp = 0; while (cond) { __builtin_amdgcn_s_sleep(1); \
    if ((++_sp & 255u) == 0u) { if (xb_ld(&(bar)[XB_TMO])) break; if (_sp > XB_SPIN_CAP) { atomicAdd(&(bar)[XB_TMO], 1u); break; } } } } while (0)

struct XcdBarrier {
    unsigned* bar; unsigned x;
    volatile LAS unsigned* st;
};

__device__ __forceinline__ XcdBarrier xcd_barrier_post(unsigned* bar, volatile LAS unsigned* st, bool is_t0  ) {
    XcdBarrier b; b.bar = bar; b.x = xb_xcc_id(); b.st = st;
    if (is_t0) (void)xb_add(&bar[XB_XCNT(b.x)], 1u);
    return b;
}
__device__ __forceinline__ void xcd_barrier_complete(unsigned* bar, unsigned x, unsigned& nloc, unsigned& nx) {
    const unsigned G = gridDim.x * gridDim.y * gridDim.z;
    unsigned sum, cnt, mine, sp = 0u;
    for (;;) {
        sum = 0u; cnt = 0u; mine = 0u;
#pragma unroll
        for (unsigned j = 0; j < 16; ++j) { const unsigned c = xb_ld(&bar[XB_XCNT(j)]); sum += c; cnt += (c > 0u) ? 1u : 0u; mine = (j == x) ? c : mine; }
        if (sum == G) break;
        __builtin_amdgcn_s_sleep(1);
        if ((++sp & 255u) == 0u) { if (xb_ld(&bar[XB_TMO])) break; if (sp > XB_SPIN_CAP) { atomicAdd(&bar[XB_TMO], 1u); break; } }
    }
    nloc = mine > 0u ? mine : 1u; nx = cnt > 0u ? cnt : 1u;
}

__device__ __forceinline__ void xcd_barrier(const XcdBarrier& b, bool is_t0) {
    asm volatile("s_waitcnt vmcnt(0)" ::: "memory");
    __syncthreads();
    if (is_t0) {
        unsigned* bar = b.bar;
        __builtin_amdgcn_s_waitcnt(0);
        unsigned nloc = b.st[0], nx = b.st[1];
        if (nloc == 0u) { xcd_barrier_complete(bar, b.x, nloc, nx); b.st[0] = nloc; b.st[1] = nx; }
        const unsigned old = xb_add(&bar[XB_XSUB(b.x)], 1u);
        const unsigned gen = old / nloc;
        if (old + 1u == (gen + 1u) * nloc) {
            __builtin_amdgcn_fence(__ATOMIC_RELEASE, "agent");
            asm volatile("s_waitcnt vmcnt(0)" ::: "memory");
            const unsigned og = xb_add(&bar[XB_TOP], 1u);
            const unsigned tg = og / nx;
            if (og + 1u == (tg + 1u) * nx) xb_add(&bar[XB_TOPGEN], 1u);
            else XB_SPIN(xb_ld(&bar[XB_TOPGEN]) == tg, bar);
            __builtin_amdgcn_fence(__ATOMIC_ACQUIRE, "agent");
            xb_add(&bar[XB_XGEN(b.x)], 1u);
            asm volatile("s_waitcnt vmcnt(0)" ::: "memory");
        } else {
            XB_SPIN(xb_ld(&bar[XB_XGEN(b.x)]) == gen, bar);
            __builtin_amdgcn_fence(__ATOMIC_ACQUIRE, "agent");
            asm volatile("s_waitcnt vmcnt(0)" ::: "memory");
        }
    }
    __syncthreads();
}

constexpr int PROJ_N1 = 16 * 256;
constexpr int LDS_BAR_OFF = IDX_LDS;
constexpr int MEGA_LDS = LDS_BAR_OFF + 16;
static_assert(IDX_LDS >= LOC_LDS && IDX_LDS >= pg8::STAGE_BYTES && IDX_LDS >= att::LDS_BYTES && (IDX_LDS % 16) == 0, "LDS carve");
struct MegaParams { const float* x_in; const float* c_in; const float* positions; const float* rel_bias; const float* w_mod; const float* b_mod; const float* g_pre_mix; const float* g_post_mix; const float* g_pre_mlp; const float* g_post_mlp; const float* w_in; const float* pool_w; const float* pool_scale; const float* conv_w; const float* conv_b; const float* gate_r_w; const float* gate_r_b; const float* gate_i_w; const float* gate_i_b; const float* lru_lambda; const float* g_attn_out; const float* g_pool_out; const float* g_lru_out; const float* w_out; const float* w_up; const float* w_down; float* out; unsigned char* ws; };
constexpr size_t al256(size_t x) { return (x + 255) & ~(size_t)255; }
constexpr size_t WS_BAR = 0, WS_CNT = (size_t)XCD_BAR_WORDS * 4  , WS_ZERO_BYTES = WS_CNT + (size_t)8 * 32 * 64 * 4,
    WS_SLOTS = al256(WS_ZERO_BYTES)  , WS_MOD = al256(WS_SLOTS + (size_t)8 * 32 * 256 * 8 * 4), WS_WIN = al256(WS_MOD + (size_t)DEPTH * 6 * D * 4), WS_WOUT = al256(WS_WIN + (size_t)DEPTH * INP * D * 2),
    WS_WUP = al256(WS_WOUT + (size_t)DEPTH * D * D * 2), WS_WDOWN = al256(WS_WUP + (size_t)DEPTH * MLPH * D * 2), WS_PWT = al256(WS_WDOWN + (size_t)DEPTH * D * MLPH * 2),
    WS_RWT = al256(WS_PWT + (size_t)DEPTH * 4 * 128 * 128 * 2), WS_IWT = al256(WS_RWT + (size_t)DEPTH * 4 * 128 * 128 * 2), WS_REGA = al256(WS_IWT + (size_t)DEPTH * 4 * 128 * 128 * 2),
    WS_H16 = al256(WS_REGA + (size_t)L * L * 4), WS_QKV = al256(WS_H16 + (size_t)L * D * 2), WS_QI = al256(WS_QKV + (size_t)3 * L * AW * 2), WS_KI = al256(WS_QI + (size_t)L * 1024 * 2), WS_WI = al256(WS_KI + (size_t)L * 64 * 2),
    WS_PL = al256(WS_WI + (size_t)L * 16 * 4), WS_MASK = al256(WS_PL + (size_t)L * 1536 * 4), WS_XW = al256(WS_MASK + (size_t)L * 128 * 8), WS_ML = al256(WS_XW + (size_t)L * D * 4),
    WS_HLOC = al256(WS_ML + (size_t)2 * NH * L * 2 * 4), WS_PP = al256(WS_HLOC + (size_t)L * LW * 4), WS_ACAR = al256(WS_PP + (size_t)L * LW * 4), WS_HCAR = al256(WS_ACAR + (size_t)256 * LW * 4),
    WS_APRE = al256(WS_HCAR + (size_t)256 * LW * 4), WS_HPRE = al256(WS_APRE + (size_t)256 * LW * 4), WS_AG = al256(WS_HPRE + (size_t)256 * LW * 4), WS_HG = al256(WS_AG + (size_t)16 * LW * 4),
    WS_END = al256(WS_HG + (size_t)16 * LW * 4);
constexpr size_t WS_S = WS_REGA, WS_U16 = WS_REGA, WS_Y = WS_REGA + (size_t)L * MLPH * 2, WS_OPART = WS_REGA + (size_t)L * MLPH * 3;
#define GBAR() do { PHASE_ENTER(); (void)blk; XcdBarrier bar_; bar_.bar = WSP(unsigned, WS_BAR); bar_.x = xb_xcc_id(); bar_.st = (volatile LAS unsigned*)(lds + LDS_BAR_OFF); \
    xcd_barrier(bar_, phase_tid(w0) == 0); } while (0)
__global__ __launch_bounds__(512, 2) void k_mega(MegaParams P) {
    (void)P;
    extern __shared__ __attribute__((aligned(16))) unsigned char shm[];
    LAS unsigned char* lds = (LAS unsigned char*)shm;
#define PHASE_ENTER() unsigned zoff_ = 0u; int blk = (int)blockIdx.x; asm volatile("" : "+s"(zoff_), "+s"(blk)); \
    const MegaParams* const PP = (const MegaParams*)((const __attribute__((address_space(4))) char*)__builtin_amdgcn_kernarg_segment_ptr() + zoff_);     \
    unsigned char* const ws = PP->ws + zoff_
#define WSP(T, off) ((T*)(ws + (off)))
    const int w0 = __builtin_amdgcn_readfirstlane((int)threadIdx.x >> 6);
    { const int t0 = phase_tid(w0); if (t0 < 4) ((LAS unsigned*)(lds + LDS_BAR_OFF))[t0] = 0u; }
    __syncthreads();
    { PHASE_ENTER(); (void)blk; (void)xcd_barrier_post(WSP(unsigned, WS_BAR), (volatile LAS unsigned*)(lds + LDS_BAR_OFF), phase_tid(w0) == 0); }
    { PHASE_ENTER();
      ProParams pp; pp.c = PP->c_in; pp.w_mod = PP->w_mod; pp.b_mod = PP->b_mod; pp.mod = WSP(float, WS_MOD); pp.w_in = PP->w_in; pp.w_out = PP->w_out; pp.w_up = PP->w_up; pp.w_down = PP->w_down;
      pp.wt_in = WSP(f16, WS_WIN); pp.wt_out = WSP(f16, WS_WOUT); pp.wt_up = WSP(f16, WS_WUP); pp.wt_down = WSP(f16, WS_WDOWN); pp.pool_w = PP->pool_w; pp.r_w = PP->gate_r_w; pp.i_w = PP->gate_i_w;
      pp.poolWt = WSP(f16, WS_PWT); pp.rWt = WSP(f16, WS_RWT); pp.iWt = WSP(f16, WS_IWT);
      prologue_phase(blk, pp, (LAS float*)lds, w0); }
    GBAR();
    { PHASE_ENTER(); norm_pre_phase(blk, PP->x_in, PP->g_pre_mix, WSP(float, WS_MOD) + D, WSP(float, WS_MOD), WSP(f16, WS_H16), w0); }
    GBAR();
    { constexpr int l = 0;
        { PHASE_ENTER();
          pg8::Gemm g; g.A = WSP(f16, WS_H16); g.Bt = WSP(f16, WS_WIN) + (size_t)l * INP * D; g.M = L; g.N = PROJ_N1; g.K = D; g.wexp = 127;
          pg8::EpiProj e; e.qkv = WSP(f16, WS_QKV); e.qi = WSP(f16, WS_QI); e.ki = WSP(f16, WS_KI); e.wi = WSP(float, WS_WI); e.pl = WSP(f16, WS_PL); e.pn0 = 0; e.pad = 0;
          pg8::StaticOrder S; S.init(g.M, g.N, NBLK, blk);
          pg8::gemm_phase<pg8::EpiProj, pg8::StaticOrder>(lds, g, S, e, w0); }
        GBAR();
        { PHASE_ENTER();
          pg8::Gemm g; g.A = WSP(f16, WS_H16); g.Bt = WSP(f16, WS_WIN) + (size_t)l * INP * D + (size_t)PROJ_N1 * D; g.M = L; g.N = INP - PROJ_N1; g.K = D; g.wexp = 127;
          pg8::EpiProj e; e.qkv = WSP(f16, WS_QKV); e.qi = WSP(f16, WS_QI); e.ki = WSP(f16, WS_KI); e.wi = WSP(float, WS_WI); e.pl = WSP(f16, WS_PL); e.pn0 = PROJ_N1 / 256; e.pad = 0;
          pg8::StaticOrder S; S.init(g.M, g.N, NBLK, blk);
          pg8::gemm_phase<pg8::EpiProj, pg8::StaticOrder>(lds, g, S, e, w0); }
        { PHASE_ENTER(); idx_phase(blk, WSP(f16, WS_QI), WSP(f16, WS_KI), WSP(float, WS_WI), WSP(float, WS_S), lds, w0); }
        { PHASE_ENTER();
          LocParams lp; lp.pl = WSP(f16, WS_PL); lp.poolWt = WSP(f16, WS_PWT) + (size_t)l * 4 * 128 * 128; lp.rWt = WSP(f16, WS_RWT) + (size_t)l * 4 * 128 * 128; lp.iWt = WSP(f16, WS_IWT) + (size_t)l * 4 * 128 * 128;
          lp.pool_scale = PP->pool_scale + (size_t)l * PW; lp.g_pool = PP->g_pool_out + (size_t)l * PW; lp.conv_w = PP->conv_w + (size_t)l * 4 * LW; lp.conv_b = PP->conv_b + (size_t)l * LW;
          lp.r_b = PP->gate_r_b + (size_t)l * LW; lp.i_b = PP->gate_i_b + (size_t)l * LW; lp.lam = PP->lru_lambda + (size_t)l * LW; lp.hloc = WSP(float, WS_HLOC); lp.Pp = WSP(float, WS_PP);
          lp.Acar = WSP(float, WS_ACAR); lp.Hcar = WSP(float, WS_HCAR); lp.mixed16 = WSP(f16, WS_H16); lp.m8 = (l == DEPTH - 1) ? 1 : 0; lp.pad = 0;
          local_phase(blk, lp, lds, w0); }
        GBAR();
        { PHASE_ENTER(); select_phase(blk, WSP(float, WS_S), WSP(unsigned long long, WS_MASK), lds, w0, WSP(f16, WS_QKV) + (size_t)16 * L * 128);
          if (blk < 16) carry_phase(blk, WSP(float, WS_ACAR), WSP(float, WS_HCAR), WSP(float, WS_APRE), WSP(float, WS_HPRE), WSP(float, WS_AG), WSP(float, WS_HG), w0); }
        GBAR();
        { PHASE_ENTER(); attn_phase(blk, WSP(f16, WS_QKV), WSP(unsigned long long, WS_MASK), PP->rel_bias, WSP(f16, WS_OPART), WSP(float, WS_ML), (char*)shm, w0); }
        GBAR();
        { PHASE_ENTER();
          MixParams mp; mp.Opart = WSP(f16, WS_OPART); mp.ML = WSP(float, WS_ML); mp.hloc = WSP(float, WS_HLOC); mp.Pp = WSP(float, WS_PP); mp.Apre = WSP(float, WS_APRE); mp.Hpre = WSP(float, WS_HPRE);
          mp.AG = WSP(float, WS_AG); mp.HG = WSP(float, WS_HG); mp.pl = WSP(f16, WS_PL);
          mp.g_attn = PP->g_attn_out + (size_t)l * AW; mp.g_lru = PP->g_lru_out + (size_t)l * LW; mp.mixed16 = WSP(f16, WS_H16); mp.m8 = (l == DEPTH - 1) ? 1 : 0; mp.pad = 0;
          mix_phase(blk, mp, lds, w0); }
        GBAR();
        { PHASE_ENTER(); const float* m = WSP(float, WS_MOD) + (size_t)l * 6 * D;
          pg8::Gemm g; g.A = WSP(f16, WS_H16); g.Bt = WSP(f16, WS_WOUT) + (size_t)l * D * D; g.M = L; g.N = D; g.K = D; g.wexp = 127;
          pg8::EpiResNorm e; e.xi = l == 0 ? PP->x_in : WSP(float, WS_XW); e.xo = WSP(float, WS_XW); e.mod = m; e.o_gate = 2 * D; e.gpost = PP->g_post_mix + (size_t)l * D;
          e.gpre = PP->g_pre_mlp + (size_t)l * D; e.o_scale = 4 * D; e.o_shift = 3 * D; e.h = WSP(f16, WS_H16);
          e.slots = WSP(float, WS_SLOTS); e.cnt = WSP(unsigned, WS_CNT); e.use = l * 4 + 0; e.h8 = 1; e.x16 = (l == 0 ? 0 : 1) | 2;
          pg8::StaticOrder S; S.init(g.M, g.N, NBLK, blk);
          if constexpr (l == DEPTH - 1) { g.wexp = 121; pg8::gemm_phase<pg8::EpiResNorm, pg8::StaticOrder, true, true, true>(lds, g, S, e, w0); }
          else pg8::gemm_phase<pg8::EpiResNorm, pg8::StaticOrder>(lds, g, S, e, w0); }
        GBAR();
        { PHASE_ENTER();
          pg8::Gemm g; g.A = WSP(f16, WS_H16); g.Bt = WSP(f16, WS_WUP) + (size_t)l * MLPH * D; g.M = L; g.N = MLPH; g.K = D; g.wexp = 127;
          pg8::StaticOrder S; S.init(g.M, g.N, NBLK, blk);
          { g.wexp = 121;
              pg8::EpiRelu2F8 e; e.O = WSP(unsigned char, WS_U16); e.ldc = MLPH; e.pad = 0; pg8::gemm_phase<pg8::EpiRelu2F8, pg8::StaticOrder, true, true, true>(lds, g, S, e, w0); } }
        GBAR();
        { PHASE_ENTER(); const float* m = WSP(float, WS_MOD) + (size_t)l * 6 * D;
          pg8::Gemm g; g.A = WSP(f16, WS_U16); g.Bt = WSP(f16, WS_WDOWN) + (size_t)l * D * MLPH; g.M = L; g.N = D; g.K = MLPH; g.wexp = 127;
          pg8::EpiResNorm e; e.xi = WSP(float, WS_XW); e.xo = (l == DEPTH - 1) ? PP->out : WSP(float, WS_XW); e.mod = m; e.o_gate = 5 * D; e.gpost = PP->g_post_mlp + (size_t)l * D;
          e.gpre = (l == DEPTH - 1) ? nullptr : PP->g_pre_mix + (size_t)(l + 1) * D; e.o_scale = 7 * D; e.o_shift = 6 * D; e.h = (l == DEPTH - 1) ? nullptr : WSP(f16, WS_H16);
          e.slots = WSP(float, WS_SLOTS); e.cnt = WSP(unsigned, WS_CNT); e.use = l * 4 + 2; e.h8 = 0; e.x16 = 1 | ((l == DEPTH - 1) ? 0 : 2);
          pg8::StaticOrder S; S.init(g.M, g.N, NBLK, blk);
          g.wexp = 120; pg8::gemm_phase<pg8::EpiResNorm, pg8::StaticOrder, true, true, true>(lds, g, S, e, w0); }
        if (l != DEPTH - 1) GBAR();
    }
    { constexpr int l = 1;
        { PHASE_ENTER();
          pg8::Gemm g; g.A = WSP(f16, WS_H16); g.Bt = WSP(f16, WS_WIN) + (size_t)l * INP * D; g.M = L; g.N = PROJ_N1; g.K = D; g.wexp = 127;
          pg8::EpiProj e; e.qkv = WSP(f16, WS_QKV); e.qi = WSP(f16, WS_QI); e.ki = WSP(f16, WS_KI); e.wi = WSP(float, WS_WI); e.pl = WSP(f16, WS_PL); e.pn0 = 0; e.pad = 0;
          pg8::StaticOrder S; S.init(g.M, g.N, NBLK, blk);
          pg8::gemm_phase<pg8::EpiProj, pg8::StaticOrder>(lds, g, S, e, w0); }
        GBAR();
        { PHASE_ENTER();
          pg8::Gemm g; g.A = WSP(f16, WS_H16); g.Bt = WSP(f16, WS_WIN) + (size_t)l * INP * D + (size_t)PROJ_N1 * D; g.M = L; g.N = INP - PROJ_N1; g.K = D; g.wexp = 127;
          pg8::EpiProj e; e.qkv = WSP(f16, WS_QKV); e.qi = WSP(f16, WS_QI); e.ki = WSP(f16, WS_KI); e.wi = WSP(float, WS_WI); e.pl = WSP(f16, WS_PL); e.pn0 = PROJ_N1 / 256; e.pad = 0;
          pg8::StaticOrder S; S.init(g.M, g.N, NBLK, blk);
          pg8::gemm_phase<pg8::EpiProj, pg8::StaticOrder>(lds, g, S, e, w0); }
        { PHASE_ENTER(); idx_phase(blk, WSP(f16, WS_QI), WSP(f16, WS_KI), WSP(float, WS_WI), WSP(float, WS_S), lds, w0); }
        { PHASE_ENTER();
          LocParams lp; lp.pl = WSP(f16, WS_PL); lp.poolWt = WSP(f16, WS_PWT) + (size_t)l * 4 * 128 * 128; lp.rWt = WSP(f16, WS_RWT) + (size_t)l * 4 * 128 * 128; lp.iWt = WSP(f16, WS_IWT) + (size_t)l * 4 * 128 * 128;
          lp.pool_scale = PP->pool_scale + (size_t)l * PW; lp.g_pool = PP->g_pool_out + (size_t)l * PW; lp.conv_w = PP->conv_w + (size_t)l * 4 * LW; lp.conv_b = PP->conv_b + (size_t)l * LW;
          lp.r_b = PP->gate_r_b + (size_t)l * LW; lp.i_b = PP->gate_i_b + (size_t)l * LW; lp.lam = PP->lru_lambda + (size_t)l * LW; lp.hloc = WSP(float, WS_HLOC); lp.Pp = WSP(float, WS_PP);
          lp.Acar = WSP(float, WS_ACAR); lp.Hcar = WSP(float, WS_HCAR); lp.mixed16 = WSP(f16, WS_H16); lp.m8 = (l == DEPTH - 1) ? 1 : 0; lp.pad = 0;
          local_phase(blk, lp, lds, w0); }
        GBAR();
        { PHASE_ENTER(); select_phase(blk, WSP(float, WS_S), WSP(unsigned long long, WS_MASK), lds, w0, WSP(f16, WS_QKV) + (size_t)16 * L * 128);
          if (blk < 16) carry_phase(blk, WSP(float, WS_ACAR), WSP(float, WS_HCAR), WSP(float, WS_APRE), WSP(float, WS_HPRE), WSP(float, WS_AG), WSP(float, WS_HG), w0); }
        GBAR();
        { PHASE_ENTER(); attn_phase(blk, WSP(f16, WS_QKV), WSP(unsigned long long, WS_MASK), PP->rel_bias, WSP(f16, WS_OPART), WSP(float, WS_ML), (char*)shm, w0); }
        GBAR();
        { PHASE_ENTER();
          MixParams mp; mp.Opart = WSP(f16, WS_OPART); mp.ML = WSP(float, WS_ML); mp.hloc = WSP(float, WS_HLOC); mp.Pp = WSP(float, WS_PP); mp.Apre = WSP(float, WS_APRE); mp.Hpre = WSP(float, WS_HPRE);
          mp.AG = WSP(float, WS_AG); mp.HG = WSP(float, WS_HG); mp.pl = WSP(f16, WS_PL);
          mp.g_attn = PP->g_attn_out + (size_t)l * AW; mp.g_lru = PP->g_lru_out + (size_t)l * LW; mp.mixed16 = WSP(f16, WS_H16); mp.m8 = (l == DEPTH - 1) ? 1 : 0; mp.pad = 0;
          mix_phase(blk, mp, lds, w0); }
        GBAR();
        { PHASE_ENTER(); const float* m = WSP(float, WS_MOD) + (size_t)l * 6 * D;
          pg8::Gemm g; g.A = WSP(f16, WS_H16); g.Bt = WSP(f16, WS_WOUT) + (size_t)l * D * D; g.M = L; g.N = D; g.K = D; g.wexp = 127;
          pg8::EpiResNorm e; e.xi = l == 0 ? PP->x_in : WSP(float, WS_XW); e.xo = WSP(float, WS_XW); e.mod = m; e.o_gate = 2 * D; e.gpost = PP->g_post_mix + (size_t)l * D;
          e.gpre = PP->g_pre_mlp + (size_t)l * D; e.o_scale = 4 * D; e.o_shift = 3 * D; e.h = WSP(f16, WS_H16);
          e.slots = WSP(float, WS_SLOTS); e.cnt = WSP(unsigned, WS_CNT); e.use = l * 4 + 0; e.h8 = 1; e.x16 = (l == 0 ? 0 : 1) | 2;
          pg8::StaticOrder S; S.init(g.M, g.N, NBLK, blk);
          if constexpr (l == DEPTH - 1) { g.wexp = 121; pg8::gemm_phase<pg8::EpiResNorm, pg8::StaticOrder, true, true, true>(lds, g, S, e, w0); }
          else pg8::gemm_phase<pg8::EpiResNorm, pg8::StaticOrder>(lds, g, S, e, w0); }
        GBAR();
        { PHASE_ENTER();
          pg8::Gemm g; g.A = WSP(f16, WS_H16); g.Bt = WSP(f16, WS_WUP) + (size_t)l * MLPH * D; g.M = L; g.N = MLPH; g.K = D; g.wexp = 127;
          pg8::StaticOrder S; S.init(g.M, g.N, NBLK, blk);
          { g.wexp = 121;
              pg8::EpiRelu2F8 e; e.O = WSP(unsigned char, WS_U16); e.ldc = MLPH; e.pad = 0; pg8::gemm_phase<pg8::EpiRelu2F8, pg8::StaticOrder, true, true, true>(lds, g, S, e, w0); } }
        GBAR();
        { PHASE_ENTER(); const float* m = WSP(float, WS_MOD) + (size_t)l * 6 * D;
          pg8::Gemm g; g.A = WSP(f16, WS_U16); g.Bt = WSP(f16, WS_WDOWN) + (size_t)l * D * MLPH; g.M = L; g.N = D; g.K = MLPH; g.wexp = 127;
          pg8::EpiResNorm e; e.xi = WSP(float, WS_XW); e.xo = (l == DEPTH - 1) ? PP->out : WSP(float, WS_XW); e.mod = m; e.o_gate = 5 * D; e.gpost = PP->g_post_mlp + (size_t)l * D;
          e.gpre = (l == DEPTH - 1) ? nullptr : PP->g_pre_mix + (size_t)(l + 1) * D; e.o_scale = 7 * D; e.o_shift = 6 * D; e.h = (l == DEPTH - 1) ? nullptr : WSP(f16, WS_H16);
          e.slots = WSP(float, WS_SLOTS); e.cnt = WSP(unsigned, WS_CNT); e.use = l * 4 + 2; e.h8 = 0; e.x16 = 1 | ((l == DEPTH - 1) ? 0 : 2);
          pg8::StaticOrder S; S.init(g.M, g.N, NBLK, blk);
          g.wexp = 120; pg8::gemm_phase<pg8::EpiResNorm, pg8::StaticOrder, true, true, true>(lds, g, S, e, w0); }
        if (l != DEPTH - 1) GBAR();
    }
}
}

extern "C" void kernel_launch(void* const* d_in, const int* in_sizes, int n_in, void* d_out, int out_size, void* d_ws, size_t ws_size, hipStream_t stream) {
    (void)in_sizes; (void)out_size;
    if (n_in != 26 || ws_size < WS_END) return;
    MegaParams P{};
    P.x_in = (const float*)d_in[0]; P.c_in = (const float*)d_in[1]; P.positions = (const float*)d_in[2]; P.rel_bias = (const float*)d_in[3]; P.w_mod = (const float*)d_in[4]; P.b_mod = (const float*)d_in[5]; P.g_pre_mix = (const float*)d_in[6]; P.g_post_mix = (const float*)d_in[7]; P.g_pre_mlp = (const float*)d_in[8]; P.g_post_mlp = (const float*)d_in[9]; P.w_in = (const float*)d_in[10]; P.pool_w = (const float*)d_in[11]; P.pool_scale = (const float*)d_in[12]; P.conv_w = (const float*)d_in[13]; P.conv_b = (const float*)d_in[14]; P.gate_r_w = (const float*)d_in[15]; P.gate_r_b = (const float*)d_in[16]; P.gate_i_w = (const float*)d_in[17]; P.gate_i_b = (const float*)d_in[18]; P.lru_lambda = (const float*)d_in[19]; P.g_attn_out = (const float*)d_in[20]; P.g_pool_out = (const float*)d_in[21]; P.g_lru_out = (const float*)d_in[22]; P.w_out = (const float*)d_in[23]; P.w_up = (const float*)d_in[24]; P.w_down = (const float*)d_in[25];
    P.out = (float*)d_out; P.ws = (unsigned char*)d_ws;
    static bool attr_done = false;
    if (!attr_done) { attr_done = true; (void)hipFuncSetAttribute((const void*)k_mega, hipFuncAttributeMaxDynamicSharedMemorySize, MEGA_LDS); }
    (void)hipMemsetAsync((unsigned char*)d_ws + WS_BAR, 0, WS_ZERO_BYTES, stream);
    hipLaunchKernelGGL(k_mega, dim3(NBLK), dim3(NTHR), MEGA_LDS, stream, P);
}
```

```cpp
#include <hip/hip_runtime.h>
#include <stdint.h>

namespace {
typedef _Float16 f16;
typedef _Float16 f16x8 __attribute__((ext_vector_type(8)));
typedef _Float16 f16x4 __attribute__((ext_vector_type(4)));
typedef _Float16 f16x2 __attribute__((ext_vector_type(2)));
typedef float f32x4 __attribute__((ext_vector_type(4)));
typedef float f32x16 __attribute__((ext_vector_type(16)));
typedef unsigned u32x4 __attribute__((ext_vector_type(4)));
typedef unsigned u32x2 __attribute__((ext_vector_type(2)));
#define LAS __attribute__((address_space(3)))

constexpr int D = 2048, L = 8192, DEPTH = 2;
constexpr int AW = 1024, NH = 8, HD = 128;
constexpr int PW = 512;
constexpr int LW = 512;
constexpr int NIH = 16, IDIM = 64;
constexpr int TOPK = 256;
constexpr int MLPH = 8192;
constexpr int INW = 5712;
constexpr int INP = 5888;
constexpr float EPS = 1e-6f;
constexpr int NBLK = 256, NTHR = 512;

__device__ __forceinline__ int phase_tid(int w0) { int t; asm volatile("v_mbcnt_lo_u32_b32 %0, -1, 0\n\tv_mbcnt_hi_u32_b32 %0, -1, %0\n\tv_lshl_or_b32 %0, %1, 6, %0" : "=&v"(t) : "s"(w0)); t &= 511; return t; }
template <int O> __device__ __forceinline__ float swz_xor(float v) { return __int_as_float(__builtin_amdgcn_ds_swizzle(__float_as_int(v), (O << 10) | 0x1F)); }
__device__ __forceinline__ float half_sum(float v) { auto r = __builtin_amdgcn_permlane32_swap(__float_as_uint(v), __float_as_uint(v), false, false); return __uint_as_float(r[0]) + __uint_as_float(r[1]); }
__device__ __forceinline__ int wave_sum_i(int v) {
    v += __builtin_amdgcn_ds_swizzle(v, (1 << 10) | 0x1F); v += __builtin_amdgcn_ds_swizzle(v, (2 << 10) | 0x1F); v += __builtin_amdgcn_ds_swizzle(v, (4 << 10) | 0x1F);
    v += __builtin_amdgcn_ds_swizzle(v, (8 << 10) | 0x1F); v += __builtin_amdgcn_ds_swizzle(v, (16 << 10) | 0x1F);
    auto r = __builtin_amdgcn_permlane32_swap((unsigned)v, (unsigned)v, false, false); return (int)(r[0] + r[1]);
}
__device__ __forceinline__ float wave_sum(float v) {
    v += swz_xor<1>(v); v += swz_xor<2>(v); v += swz_xor<4>(v); v += swz_xor<8>(v); v += swz_xor<16>(v);
    return half_sum(v);
}
__device__ __forceinline__ unsigned pack2(float a, float b) { f16x2 h = {(f16)a, (f16)b}; return *reinterpret_cast<unsigned*>(&h); }
template <bool WIN>
__device__ __forceinline__ void conv_tile(const float* __restrict__ src, int Nsrc, int K, f16* __restrict__ dst, int kt, int nt, LAS float* tile  , int w0) {
    const int tid = phase_tid(w0), k0 = kt * 64, n0 = nt * 128;
#pragma unroll
    for (int i = 0; i < 4; ++i) {
        const int idx = tid + 512 * i, row = idx >> 5, c4 = (idx & 31) * 4, np = n0 + c4;
        int col = np; bool z = false;
        if (WIN) { if (np >= 4352) col = np - 176; else if (np >= 4176) z = true; }
        f32x4 v = {0.f, 0.f, 0.f, 0.f};
        if (!z) v = *(const f32x4*)(src + (size_t)(k0 + row) * Nsrc + col);
        LAS float* tp = tile + row * 129 + c4;
        tp[0] = v[0]; tp[1] = v[1]; tp[2] = v[2]; tp[3] = v[3];
    }
    __syncthreads();
    {
        const int n = tid >> 2, kc = tid & 3;
        unsigned w[8];
#pragma unroll
        for (int i = 0; i < 8; ++i) w[i] = pack2(tile[(kc * 16 + 2 * i) * 129 + n], tile[(kc * 16 + 2 * i + 1) * 129 + n]);
        f16* dp = dst + (size_t)(n0 + n) * K + k0 + kc * 16;
        *(u32x4*)dp = (u32x4){w[0], w[1], w[2], w[3]};
        *(u32x4*)(dp + 8) = (u32x4){w[4], w[5], w[6], w[7]};
    }
    __syncthreads();
}

__device__ __forceinline__ void conv_tile_f8(const float* __restrict__ src, int Nsrc, int K, unsigned char* __restrict__ dst, int kt, int nt, float mul, LAS float* tile  , int w0) {
    const int tid = phase_tid(w0), k0 = kt * 64, n0 = nt * 128;
#pragma unroll
    for (int i = 0; i < 4; ++i) {
        const int idx = tid + 512 * i, row = idx >> 5, c4 = (idx & 31) * 4;
        const f32x4 v = *(const f32x4*)(src + (size_t)(k0 + row) * Nsrc + n0 + c4);
        LAS float* tp = tile + row * 129 + c4;
        tp[0] = v[0] * mul; tp[1] = v[1] * mul; tp[2] = v[2] * mul; tp[3] = v[3] * mul;
    }
    __syncthreads();
    {
        const int n = tid >> 2, kc = tid & 3;
        unsigned w[4];
#pragma unroll
        for (int i = 0; i < 4; ++i) { unsigned x = 0u;
            x = __builtin_amdgcn_cvt_pk_fp8_f32(tile[(kc * 16 + 4 * i) * 129 + n], tile[(kc * 16 + 4 * i + 1) * 129 + n], x, false);
            x = __builtin_amdgcn_cvt_pk_fp8_f32(tile[(kc * 16 + 4 * i + 2) * 129 + n], tile[(kc * 16 + 4 * i + 3) * 129 + n], x, true); w[i] = x; }
        *(u32x4*)(dst + (size_t)(n0 + n) * K + k0 + kc * 16) = (u32x4){w[0], w[1], w[2], w[3]};
    }
    __syncthreads();
}

__device__ __forceinline__ void mod_unit(const float* __restrict__ c, const float* __restrict__ w_mod, const float* __restrict__ b_mod, float* __restrict__ mod, int unit, LAS float* lds, int w0) {
    LAS float* sc = lds;
    LAS float* red = lds + 2048;
    const int tid = phase_tid(w0);
    for (int i = tid; i < D; i += NTHR) { const float v = c[i]; sc[i] = v / (1.0f + __expf(-v)); }
    __syncthreads();
    const int n0 = unit * 256, l = n0 / (6 * D), j0 = n0 % (6 * D), kq = tid >> 6, nl = tid & 63;
    const float* w = w_mod + (size_t)l * D * 6 * D + j0 + nl * 4;
    f32x4 acc = {0.f, 0.f, 0.f, 0.f};
#pragma unroll 8
    for (int k = kq; k < D; k += 8) { const f32x4 v = __builtin_nontemporal_load((const f32x4*)(w + (size_t)k * 6 * D)); acc += v * sc[k]; }
    red[kq * 256 + nl * 4 + 0] = acc[0]; red[kq * 256 + nl * 4 + 1] = acc[1]; red[kq * 256 + nl * 4 + 2] = acc[2]; red[kq * 256 + nl * 4 + 3] = acc[3];
    __syncthreads();
    if (tid < 256) { float s = 0.f;
#pragma unroll
        for (int q = 0; q < 8; ++q) s += red[q * 256 + tid];
        mod[n0 + tid] = s + b_mod[n0 + tid]; }
    __syncthreads();
}

struct ProParams { const float* c; const float* w_mod; const float* b_mod; float* mod; const float* w_in; const float* w_out; const float* w_up; const float* w_down;
                   f16* wt_in; f16* wt_out; f16* wt_up; f16* wt_down; const float* pool_w; const float* r_w; const float* i_w; f16* poolWt; f16* rWt; f16* iWt; };
constexpr int CT_IN = 32 * 46, CT_OUT = 32 * 16, CT_UP = 32 * 64, CT_DOWN = 128 * 16, CT_SM = 24, CT_LAYER = CT_IN + CT_OUT + CT_UP + CT_DOWN + CT_SM, CT_TOTAL = DEPTH * CT_LAYER;
struct CTile { const float* src; unsigned char* dst; int Nsrc, K, k0, n0, mode; float mul; };
#define CT_DESC(c, t_) do { const int l = (t_) / CT_LAYER; int r = (t_) % CT_LAYER; const bool last = (l == DEPTH - 1); (c).mul = 1.f; (c).mode = 0;                       \
    if (r < CT_IN) { (c).src = q_w_in + (size_t)l * D * INW; (c).dst = (unsigned char*)(q_wt_in + (size_t)l * INP * D); (c).Nsrc = INW; (c).K = D; (c).k0 = (2 * ((r >> 1) / 46) + (r & 1)) * 64; (c).n0 = ((r >> 1) % 46) * 128; (c).mode = 1; } \
    else if (r < CT_IN + CT_OUT) { r -= CT_IN; (c).src = q_w_out + (size_t)l * D * D; (c).dst = (unsigned char*)(q_wt_out + (size_t)l * D * D); (c).Nsrc = D; (c).K = D; (c).k0 = (2 * ((r >> 1) / 16) + (r & 1)) * 64; (c).n0 = ((r >> 1) % 16) * 128; \
                      (c).mode = 2; (c).mul = 64.0f; }                                                         \
    else if (r < CT_IN + CT_OUT + CT_UP) { r -= CT_IN + CT_OUT; (c).src = q_w_up + (size_t)l * D * MLPH; (c).dst = (unsigned char*)(q_wt_up + (size_t)l * MLPH * D); (c).Nsrc = MLPH; (c).K = D; (c).k0 = (2 * ((r >> 1) / 64) + (r & 1)) * 64; (c).n0 = ((r >> 1) % 64) * 128; \
                     (c).mode = 2; (c).mul = 64.0f; }                                                          \
    else if (r < CT_IN + CT_OUT + CT_UP + CT_DOWN) { r -= CT_IN + CT_OUT + CT_UP; (c).src = q_w_down + (size_t)l * MLPH * D; (c).dst = (unsigned char*)(q_wt_down + (size_t)l * D * MLPH); (c).Nsrc = D; (c).K = MLPH; (c).k0 = (2 * ((r >> 1) / 16) + (r & 1)) * 64; (c).n0 = ((r >> 1) % 16) * 128; \
                       (c).mode = 2; (c).mul = 128.0f; }                                                        \
    else { r -= CT_IN + CT_OUT + CT_UP + CT_DOWN; const int mat = r >> 1, kt = r & 1, which = mat >> 2, g = mat & 3; const size_t o = (size_t)(l * 4 + g) * 128 * 128;       \
      if (which == 0) { (c).src = q_pool_w + o; (c).dst = (unsigned char*)(q_poolWt + o); } else if (which == 1) { (c).src = q_r_w + o; (c).dst = (unsigned char*)(q_rWt + o); }   \
      else { (c).src = q_i_w + o; (c).dst = (unsigned char*)(q_iWt + o); }                                                                                                          \
      (c).Nsrc = 128; (c).K = 128; (c).k0 = kt * 64; (c).n0 = 0; } } while (0)
__device__ __forceinline__ void ct_load(const CTile& c, int tid, f32x4 (&v)[4]) {
#pragma unroll
    for (int i = 0; i < 4; ++i) {
        const int idx = tid + 512 * i, row = idx >> 5, c4 = (idx & 31) * 4, np = c.n0 + c4;
        int col = np; bool z = false;
        if (c.mode == 1) {
            if (np < 1024) col = 3072 + np; else if (np < 1104) col = 4096 + (np - 1024); else if (np < 1280) { z = true; col = 0; } else if (np < 2816) col = 4176 + (np - 1280); else col = np - 2816; }
        const f32x4 ld = __builtin_nontemporal_load((const f32x4*)(c.src + (size_t)(c.k0 + row) * c.Nsrc + col));
        v[i] = z ? f32x4{0.f, 0.f, 0.f, 0.f} : ld;
    }
}
__device__ __forceinline__ void ct_store(const CTile& c, int tid, const f32x4 (&v)[4], LAS float* tile  ) {
#pragma unroll
    for (int i = 0; i < 4; ++i) {
        const int idx = tid + 512 * i, row = idx >> 5, c4 = (idx & 31) * 4;
        LAS float* tp = tile + row * 129 + c4;
        tp[0] = v[i][0] * c.mul; tp[1] = v[i][1] * c.mul; tp[2] = v[i][2] * c.mul; tp[3] = v[i][3] * c.mul;
    }
    __syncthreads();
    const int n = tid >> 2, kc = tid & 3;
    if (c.mode == 2) {
        unsigned w[4];
#pragma unroll
        for (int i = 0; i < 4; ++i) { unsigned x = 0u;
            x = __builtin_amdgcn_cvt_pk_fp8_f32(tile[(kc * 16 + 4 * i) * 129 + n], tile[(kc * 16 + 4 * i + 1) * 129 + n], x, false);
            x = __builtin_amdgcn_cvt_pk_fp8_f32(tile[(kc * 16 + 4 * i + 2) * 129 + n], tile[(kc * 16 + 4 * i + 3) * 129 + n], x, true); w[i] = x; }
        *(u32x4*)(c.dst + (size_t)(c.n0 + n) * c.K + c.k0 + kc * 16) = (u32x4){w[0], w[1], w[2], w[3]};
    } else {
        unsigned w[8];
#pragma unroll
        for (int i = 0; i < 8; ++i) w[i] = pack2(tile[(kc * 16 + 2 * i) * 129 + n], tile[(kc * 16 + 2 * i + 1) * 129 + n]);
        f16* dp = (f16*)c.dst + (size_t)(c.n0 + n) * c.K + c.k0 + kc * 16;
        *(u32x4*)dp = (u32x4){w[0], w[1], w[2], w[3]};
        *(u32x4*)(dp + 8) = (u32x4){w[4], w[5], w[6], w[7]};
    }
    __syncthreads();
}
__device__ __forceinline__ void prologue_phase(int blk, const ProParams& p, LAS float* lds, int w0) {
    constexpr int NMOD = 96, T1 = (CT_TOTAL - (NBLK - NMOD) * 43) / NBLK, REST = CT_TOTAL - NMOD * T1, NB2 = NBLK - NMOD, Q = REST / NB2, R = REST % NB2;
    static_assert((T1 & 1) == 0 && (CT_TOTAL & 1) == 0, "pairs");
    constexpr int P1 = T1 / 2, REST2 = CT_TOTAL / 2 - NMOD * P1, Q2 = REST2 / NB2, R2 = REST2 % NB2;
    int lo, hi, base, strd;
    if (blk < NMOD) { base = blk; strd = NMOD; lo = 0; hi = 2 * P1; }
    else { const int b = blk - NMOD; base = NMOD * P1 + b; strd = NB2; lo = 0; hi = 2 * (Q2 + (b < R2 ? 1 : 0)); }
#define CT_ID(s_) (2 * (base + ((s_) >> 1) * strd) + ((s_) & 1))
    if (blk < NMOD) mod_unit(p.c, p.w_mod, p.b_mod, p.mod, blk, lds, w0);
    const float* q_w_in = p.w_in; asm volatile("" : "+s"(q_w_in));
    const float* q_w_out = p.w_out; asm volatile("" : "+s"(q_w_out));
    const float* q_w_up = p.w_up; asm volatile("" : "+s"(q_w_up));
    const float* q_w_down = p.w_down; asm volatile("" : "+s"(q_w_down));
    const float* q_pool_w = p.pool_w; asm volatile("" : "+s"(q_pool_w));
    const float* q_r_w = p.r_w; asm volatile("" : "+s"(q_r_w));
    const float* q_i_w = p.i_w; asm volatile("" : "+s"(q_i_w));
    f16* q_wt_in = p.wt_in; asm volatile("" : "+s"(q_wt_in));
    f16* q_wt_out = p.wt_out; asm volatile("" : "+s"(q_wt_out));
    f16* q_wt_up = p.wt_up; asm volatile("" : "+s"(q_wt_up));
    f16* q_wt_down = p.wt_down; asm volatile("" : "+s"(q_wt_down));
    f16* q_poolWt = p.poolWt; asm volatile("" : "+s"(q_poolWt));
    f16* q_rWt = p.rWt; asm volatile("" : "+s"(q_rWt));
    f16* q_iWt = p.iWt; asm volatile("" : "+s"(q_iWt));
    const int tid = phase_tid(w0);
    CTile cur; CT_DESC(cur, CT_ID(lo)); f32x4 va[4], vb[4];
    ct_load(cur, tid, va);
    for (int t = lo; t < hi; ++t) {
        CTile nxt; CT_DESC(nxt, CT_ID(t + 1 < hi ? t + 1 : t));
        ct_load(nxt, tid, vb);
        ct_store(cur, tid, va, lds);
        cur = nxt;
#pragma unroll
        for (int i = 0; i < 4; ++i) va[i] = vb[i];
    }
}

__device__ __forceinline__ void norm_pre_phase(int blk, const float* __restrict__ x, const float* __restrict__ g, const float* __restrict__ scale, const float* __restrict__ shift, f16* __restrict__ h, int w0) {
    const int tid = phase_tid(w0), lane = tid & 63, wv = blk * 8 + __builtin_amdgcn_readfirstlane(tid >> 6);
    for (int t = wv; t < L; t += NBLK * 8) {
        const float* xr = x + (size_t)t * D; f32x4 v[8]; float ss = 0.f;
#pragma unroll
        for (int i = 0; i < 8; ++i) { v[i] = *(const f32x4*)(xr + (i * 64 + lane) * 4); ss += v[i][0] * v[i][0] + v[i][1] * v[i][1] + v[i][2] * v[i][2] + v[i][3] * v[i][3]; }
        ss = wave_sum(ss);
        const float r = rsqrtf(ss * (1.0f / D) + EPS);
#pragma unroll
        for (int i = 0; i < 8; ++i) { const int d = (i * 64 + lane) * 4;
            const f32x4 gg = *(const f32x4*)(g + d), sc = *(const f32x4*)(scale + d), sh = *(const f32x4*)(shift + d);
            const f32x4 o = v[i] * r * gg * (sc + 1.0f) + sh;
            *(u32x2*)(h + (size_t)t * D + d) = (u32x2){pack2(o[0], o[1]), pack2(o[2], o[3])}; }
    }
}
__device__ __forceinline__ void resid_norm_phase(int blk, const float* xi, const float* __restrict__ y, const float* __restrict__ gpost, const float* __restrict__ gate, float* xo,
                                                 const float* __restrict__ gpre, const float* __restrict__ scale, const float* __restrict__ shift, f16* __restrict__ h, int w0) {
    const int tid = phase_tid(w0), lane = tid & 63, wv = blk * 8 + __builtin_amdgcn_readfirstlane(tid >> 6);
    for (int t = wv; t < L; t += NBLK * 8) {
        const float* yr = y + (size_t)t * D; const float* xr = xi + (size_t)t * D; f32x4 v[8]; float ss = 0.f;
#pragma unroll
        for (int i = 0; i < 8; ++i) { v[i] = *(const f32x4*)(yr + (i * 64 + lane) * 4); ss += v[i][0] * v[i][0] + v[i][1] * v[i][1] + v[i][2] * v[i][2] + v[i][3] * v[i][3]; }
        ss = wave_sum(ss);
        const float r = rsqrtf(ss * (1.0f / D) + EPS);
        float s2 = 0.f;
#pragma unroll
        for (int i = 0; i < 8; ++i) { const int d = (i * 64 + lane) * 4;
            const f32x4 gg = *(const f32x4*)(gpost + d), gt = *(const f32x4*)(gate + d), xv = *(const f32x4*)(xr + d);
            v[i] = xv + gt * (v[i] * r * gg);
            *(f32x4*)(xo + (size_t)t * D + d) = v[i];
            s2 += v[i][0] * v[i][0] + v[i][1] * v[i][1] + v[i][2] * v[i][2] + v[i][3] * v[i][3]; }
        if (h) {
            s2 = wave_sum(s2);
            const float r2 = rsqrtf(s2 * (1.0f / D) + EPS);
#pragma unroll
            for (int i = 0; i < 8; ++i) { const int d = (i * 64 + lane) * 4;
                const f32x4 gg = *(const f32x4*)(gpre + d), sc = *(const f32x4*)(scale + d), sh = *(const f32x4*)(shift + d);
                const f32x4 o = v[i] * r2 * gg * (sc + 1.0f) + sh;
                *(u32x2*)(h + (size_t)t * D + d) = (u32x2){pack2(o[0], o[1]), pack2(o[2], o[3])}; }
        }
    }
}
namespace pg8 {
constexpr int BM = 256, BK = 64, HALF = 128, HTB = HALF * BK * 2  , STAGE_BYTES = 8 * HTB, NXCD = 8, WGM = 8;
__host__ __device__ __forceinline__ int lds_byte(int r, int c) { const int st = (r >> 4) * 2 + (c >> 5), rr = r & 15, cc = c & 31, ob = rr * 64 + cc * 2; return st * 1024 + (ob ^ (((ob >> 9) & 1) << 5)); }
__host__ __device__ __forceinline__ void stage_rc(int b, int& R, int& C) { const int st = b / 1024, sb = b % 1024, swz = sb ^ (((sb >> 9) & 1) << 5); R = (st >> 1) * 16 + swz / 64; C = (st & 1) * 32 + (swz % 64) / 2; }
__host__ __device__ __forceinline__ int perm32(int rho) { const int n = rho >> 4, i = rho & 15; return 8 * (i >> 2) + 4 * n + (i & 3); }
struct Unit { int pm, pn; };
struct Gemm { const f16* A; const f16* Bt; int M, N, K, wexp; };
struct StaticOrder {
    int nM, nN, nwg, G, c;
    __host__ __device__ void init(int M, int N, int G_, int c_) { nM = M / BM; nN = N / BM; nwg = nM * nN; G = G_; c = c_; }
    __host__ __device__ bool next(int i, Unit& u) const {
        const long Lx = (long)i * G + c; if (Lx >= nwg) return false;
        int wgid = (int)Lx; { const int q = nwg / NXCD, r = nwg % NXCD, xcd = wgid % NXCD, off = wgid / NXCD; wgid = (xcd < r ? xcd * (q + 1) : r * (q + 1) + (xcd - r) * q) + off; }
        const int nig = WGM * nN, gid = wgid / nig, fm = gid * WGM, gsz = (nM - fm) < WGM ? (nM - fm) : WGM;
        u.pm = fm + ((wgid % nig) % gsz); u.pn = (wgid % nig) / gsz; return true;
    }
    __device__ __forceinline__ void a_ready(const Unit&) const {}
    __device__ __forceinline__ void done(const Unit&) const {}
};

struct EpiF32 {
    static constexpr bool PERM = false, AFTER_DRAIN = false;
    float* C; int ldc, pad;
    __device__ __forceinline__ void operator()(const f32x4 (&acc)[2][2][4][2], const Unit& u, int wr, int wc, int fr, int fq) const {
        const int row0 = u.pm * BM + wr * 64 + fr, col0 = u.pn * BM + wc * 32 + 4 * fq;
#pragma unroll
        for (int ai = 0; ai < 2; ++ai)
#pragma unroll
            for (int m = 0; m < 4; ++m) { float* rowp = C + (size_t)(row0 + ai * HALF + m * 16) * ldc + col0;
#pragma unroll
                for (int bj = 0; bj < 2; ++bj)
#pragma unroll
                    for (int n = 0; n < 2; ++n) *(f32x4*)(rowp + bj * HALF + n * 16) = acc[ai][bj][m][n]; }
    }
};
struct EpiRelu2 {
    static constexpr bool PERM = true, AFTER_DRAIN = false;
    f16* O; int ldc, pad;
    __device__ __forceinline__ void operator()(const f32x4 (&acc)[2][2][4][2], const Unit& u, int wr, int wc, int fr, int fq) const {
        const int row0 = u.pm * BM + wr * 64 + fr, col0 = u.pn * BM + wc * 32 + 8 * fq;
#pragma unroll
        for (int ai = 0; ai < 2; ++ai)
#pragma unroll
            for (int m = 0; m < 4; ++m) { f16* rowp = O + (size_t)(row0 + ai * HALF + m * 16) * ldc + col0;
#pragma unroll
                for (int bj = 0; bj < 2; ++bj) { f32x4 v0 = acc[ai][bj][m][0], v1 = acc[ai][bj][m][1];
#pragma unroll
                    for (int j = 0; j < 4; ++j) { v0[j] = v0[j] > 0.f ? v0[j] * v0[j] : 0.f; v1[j] = v1[j] > 0.f ? v1[j] * v1[j] : 0.f; }
                    *(u32x4*)(rowp + bj * HALF) = (u32x4){pack2(v0[0], v0[1]), pack2(v0[2], v0[3]), pack2(v1[0], v1[1]), pack2(v1[2], v1[3])}; } }
    }
};
struct EpiRelu2F8 {
    static constexpr bool PERM = true, AFTER_DRAIN = false;
    unsigned char* O; int ldc, pad;
    __device__ __forceinline__ void operator()(const f32x4 (&acc)[2][2][4][2], const Unit& u, int wr, int wc, int fr, int fq) const {
        const int row0 = u.pm * BM + wr * 64 + fr, col0 = u.pn * BM + wc * 32 + 8 * fq;
#pragma unroll
        for (int ai = 0; ai < 2; ++ai)
#pragma unroll
            for (int m = 0; m < 4; ++m) { unsigned char* rowp = O + (size_t)(row0 + ai * HALF + m * 16) * ldc + col0;
#pragma unroll
                for (int bj = 0; bj < 2; ++bj) { f32x4 v0 = acc[ai][bj][m][0], v1 = acc[ai][bj][m][1];
#pragma unroll
                    for (int j = 0; j < 4; ++j) { v0[j] = v0[j] > 0.f ? fminf(v0[j] * v0[j], 448.f) : 0.f; v1[j] = v1[j] > 0.f ? fminf(v1[j] * v1[j], 448.f) : 0.f; }
                    unsigned w0 = 0u, w1 = 0u;
                    w0 = __builtin_amdgcn_cvt_pk_fp8_f32(v0[0], v0[1], w0, false); w0 = __builtin_amdgcn_cvt_pk_fp8_f32(v0[2], v0[3], w0, true);
                    w1 = __builtin_amdgcn_cvt_pk_fp8_f32(v1[0], v1[1], w1, false); w1 = __builtin_amdgcn_cvt_pk_fp8_f32(v1[2], v1[3], w1, true);
                    *(u32x2*)(rowp + bj * HALF) = (u32x2){w0, w1}; } }
    }
};
struct EpiProj {
    static constexpr bool PERM = true, AFTER_DRAIN = false;
    f16* qkv; f16* qi; f16* ki; float* wi; f16* pl; int pn0, pad;
    __device__ __forceinline__ void operator()(const f32x4 (&acc)[2][2][4][2], const Unit& u, int wr, int wc, int fr, int fq) const {
        const int pn = u.pn + pn0;
        const int row0 = u.pm * BM + wr * 64 + fr, colt = pn * BM, cl0 = wc * 32 + 8 * fq;
        if (pn < 4 || pn >= 11) {
#pragma unroll
            for (int ai = 0; ai < 2; ++ai)
#pragma unroll
                for (int m = 0; m < 4; ++m) { const int row = row0 + ai * HALF + m * 16;
#pragma unroll
                    for (int bj = 0; bj < 2; ++bj) { const f32x4 v0 = acc[ai][bj][m][0], v1 = acc[ai][bj][m][1]; const int c = colt + cl0 + bj * HALF;
                        f16* dst;
                        if (pn >= 11) { const int cq = c - 2816; dst = qkv + ((size_t)(cq >> 7) * L + row) * HD + (cq & 127); }
                        else dst = qi + (size_t)row * 1024 + c;
                        *(u32x4*)dst = (u32x4){pack2(v0[0], v0[1]), pack2(v0[2], v0[3]), pack2(v1[0], v1[1]), pack2(v1[2], v1[3])}; } }
        } else if (pn == 4) {
            if (cl0 < 80) {
#pragma unroll
                for (int ai = 0; ai < 2; ++ai)
#pragma unroll
                    for (int m = 0; m < 4; ++m) { const int row = row0 + ai * HALF + m * 16; const f32x4 v0 = acc[ai][0][m][0], v1 = acc[ai][0][m][1];
                        if (cl0 < 64) *(u32x4*)(ki + (size_t)row * 64 + cl0) = (u32x4){pack2(v0[0], v0[1]), pack2(v0[2], v0[3]), pack2(v1[0], v1[1]), pack2(v1[2], v1[3])};
                        else { float* wp = wi + (size_t)row * 16 + (cl0 - 64); *(f32x4*)wp = v0; *(f32x4*)(wp + 4) = v1; } }
            }
        } else {
            f16* rowb = pl + (size_t)row0 * 1536 + (colt - 1280 + cl0);
#pragma unroll
            for (int ai = 0; ai < 2; ++ai)
#pragma unroll
                for (int m = 0; m < 4; ++m) { f16* rowp = rowb + (size_t)(ai * HALF + m * 16) * 1536;
#pragma unroll
                    for (int bj = 0; bj < 2; ++bj) { const f32x4 v0 = acc[ai][bj][m][0], v1 = acc[ai][bj][m][1];
                        *(u32x4*)(rowp + bj * HALF) = (u32x4){pack2(v0[0], v0[1]), pack2(v0[2], v0[3]), pack2(v1[0], v1[1]), pack2(v1[2], v1[3])}; } }
        }
    }
};


struct RowStat { float* slots; unsigned* cnt; };
__device__ __forceinline__ void panel_rstd(const f32x4 (&v)[2][2][4][2], const RowStat& st, int pm, int pn, int wr, int wc, int fr, int fq, LAS unsigned char* lds, int wid, int lane) {
    LAS float* Pt = (LAS float*)lds;
    LAS float* Rt = (LAS float*)(lds + 4096);
#pragma unroll
    for (int ai = 0; ai < 2; ++ai)
#pragma unroll
        for (int m = 0; m < 4; ++m) { float s = 0.f;
#pragma unroll
            for (int bj = 0; bj < 2; ++bj)
#pragma unroll
                for (int n = 0; n < 2; ++n) { const f32x4 x = v[ai][bj][m][n]; s += (x[0] * x[0] + x[1] * x[1]) + (x[2] * x[2] + x[3] * x[3]); }
            s += swz_xor<16>(s); s = half_sum(s);
            if (fq == 0) Pt[(ai * HALF + wr * 64 + m * 16 + fr) * 4 + wc] = s; }
    asm volatile("s_waitcnt lgkmcnt(0)" ::: "memory"); __builtin_amdgcn_s_barrier(); asm volatile("" ::: "memory");
    const int row = wid * 32 + (lane & 31);
    if (lane < 32) { const float tot = (Pt[row * 4 + 0] + Pt[row * 4 + 1]) + (Pt[row * 4 + 2] + Pt[row * 4 + 3]);
        __hip_atomic_store((unsigned*)(st.slots + ((size_t)pm * BM + row) * 8 + pn), __float_as_uint(tot), __ATOMIC_RELAXED, __HIP_MEMORY_SCOPE_AGENT); }
    asm volatile("s_waitcnt vmcnt(0)" ::: "memory");
    if (lane == 0) __hip_atomic_fetch_add(st.cnt + 64 * pm, 1u, __ATOMIC_RELAXED, __HIP_MEMORY_SCOPE_AGENT);
    if (wid == 0) {
        unsigned sp = 0;
        while ((unsigned)__builtin_amdgcn_readfirstlane(__hip_atomic_load(st.cnt + 64 * pm, __ATOMIC_RELAXED, __HIP_MEMORY_SCOPE_AGENT)) < 64u) { __builtin_amdgcn_s_sleep(2); if (++sp > (1u << 22)) break; }
        __builtin_amdgcn_fence(__ATOMIC_ACQUIRE, "agent");
    }
    asm volatile("s_waitcnt vmcnt(0) lgkmcnt(0)" ::: "memory"); __builtin_amdgcn_s_barrier(); asm volatile("" ::: "memory");
    if (lane < 32) { const float* sl = st.slots + ((size_t)pm * BM + row) * 8; float q = 0.f;
#pragma unroll
        for (int t = 0; t < 8; ++t) q += __uint_as_float(__hip_atomic_load((const unsigned*)(sl + t), __ATOMIC_RELAXED, __HIP_MEMORY_SCOPE_AGENT));
        Rt[row] = rsqrtf(q * (1.0f / D) + EPS); }
    asm volatile("s_waitcnt lgkmcnt(0)" ::: "memory"); __builtin_amdgcn_s_barrier(); asm volatile("" ::: "memory");
}
struct EpiResNorm {
    static constexpr bool PERM = true, AFTER_DRAIN = true;
    const float* xi; float* xo; const float* mod; const float* gpost; const float* gpre; f16* h; float* slots; unsigned* cnt; int o_gate, o_scale, o_shift, use, h8, x16;
    __device__ __forceinline__ void fused(f32x4 (&acc)[2][2][4][2], const Unit& u, int wr, int wc, int fr, int fq, LAS unsigned char* lds, int wid, int lane) const {
        const LAS float* Rt = (const LAS float*)(lds + 4096);
        const int col0 = u.pn * BM + wc * 32 + 8 * fq;
        const float* gate = mod + o_gate; const float* scale = mod + o_scale; const float* shift = mod + o_shift;
        RowStat s1; s1.slots = slots + (size_t)use * (32 * 256 * 8); s1.cnt = cnt + (size_t)use * (32 * 64);
        RowStat s2; s2.slots = slots + (size_t)(use + 1) * (32 * 256 * 8); s2.cnt = cnt + (size_t)(use + 1) * (32 * 64);
        f32x4 xa[4], xb[4];
#define ERN_H8(p_, A, B) do { const f16x8 h_ = *(const f16x8*)(p_); A = (f32x4){(float)h_[0], (float)h_[1], (float)h_[2], (float)h_[3]}; B = (f32x4){(float)h_[4], (float)h_[5], (float)h_[6], (float)h_[7]}; } while (0)
#define ERN_LDX(g_, X) do { const int r_ = ((g_) >> 2) * HALF + wr * 64 + ((g_) & 3) * 16 + fr; const size_t eo_ = (size_t)(u.pm * BM + r_) * D + col0;   \
            if (x16 & 1) { const f16* xh_ = (const f16*)xi + eo_; ERN_H8(xh_, X[0], X[1]); ERN_H8(xh_ + HALF, X[2], X[3]); }   \
            else { const float* xip_ = xi + eo_; X[0] = *(const f32x4*)(xip_); X[1] = *(const f32x4*)(xip_ + 4); X[2] = *(const f32x4*)(xip_ + HALF); X[3] = *(const f32x4*)(xip_ + HALF + 4); } } while (0)
        ERN_LDX(0, xa);
        f32x4 gg[2][2];
#pragma unroll
        for (int bj = 0; bj < 2; ++bj)
#pragma unroll
            for (int n = 0; n < 2; ++n) { const int c = col0 + bj * HALF + n * 4; const f32x4 g4 = *(const f32x4*)(gpost + c), t4 = *(const f32x4*)(gate + c);
                gg[bj][n] = (f32x4){g4[0] * t4[0], g4[1] * t4[1], g4[2] * t4[2], g4[3] * t4[3]}; }
        panel_rstd(acc, s1, u.pm, u.pn, wr, wc, fr, fq, lds, wid, lane);
#define ERN_GRP(g_, X) do { const int ai_ = (g_) >> 2, m_ = (g_) & 3; const int r_ = ai_ * HALF + wr * 64 + m_ * 16 + fr; const float rs_ = Rt[r_]; const size_t eo_ = (size_t)(u.pm * BM + r_) * D + col0; float* xop_ = xo + eo_;  \
            _Pragma("unroll") for (int bj = 0; bj < 2; ++bj) { f32x4 a0 = acc[ai_][bj][m_][0], a1 = acc[ai_][bj][m_][1]; const f32x4 x0 = X[bj * 2], x1 = X[bj * 2 + 1], q0 = gg[bj][0], q1 = gg[bj][1];   \
                _Pragma("unroll") for (int j = 0; j < 4; ++j) { a0[j] = fmaf(a0[j] * rs_, q0[j], x0[j]); a1[j] = fmaf(a1[j] * rs_, q1[j], x1[j]); }                                            \
                acc[ai_][bj][m_][0] = a0; acc[ai_][bj][m_][1] = a1;                                                                                                                             \
                if (x16 & 2) *(u32x4*)((f16*)xo + eo_ + bj * HALF) = (u32x4){pack2(a0[0], a0[1]), pack2(a0[2], a0[3]), pack2(a1[0], a1[1]), pack2(a1[2], a1[3])};                                \
                else { *(f32x4*)(xop_ + bj * HALF) = a0; *(f32x4*)(xop_ + bj * HALF + 4) = a1; } }                                                                                            \
            asm volatile("" ::: "memory"); } while (0)
        ERN_LDX(1, xb); ERN_GRP(0, xa);
        ERN_LDX(2, xa); ERN_GRP(1, xb);
        ERN_LDX(3, xb); ERN_GRP(2, xa);
        ERN_LDX(4, xa); ERN_GRP(3, xb);
        ERN_LDX(5, xb); ERN_GRP(4, xa);
        ERN_LDX(6, xa); ERN_GRP(5, xb);
        ERN_LDX(7, xb); ERN_GRP(6, xa);
        ERN_GRP(7, xb);
#undef ERN_LDX
#undef ERN_H8
#undef ERN_GRP
        if (h) {
            f32x4 gq[2][2], bq[2][2];
#pragma unroll
            for (int bj = 0; bj < 2; ++bj)
#pragma unroll
                for (int n = 0; n < 2; ++n) { const int c = col0 + bj * HALF + n * 4; const f32x4 g4 = *(const f32x4*)(gpre + c), s4 = *(const f32x4*)(scale + c);
                    bq[bj][n] = *(const f32x4*)(shift + c);
                    gq[bj][n] = (f32x4){g4[0] * (s4[0] + 1.0f), g4[1] * (s4[1] + 1.0f), g4[2] * (s4[2] + 1.0f), g4[3] * (s4[3] + 1.0f)}; }
            panel_rstd(acc, s2, u.pm, u.pn, wr, wc, fr, fq, lds, wid, lane);
#pragma unroll
            for (int ai = 0; ai < 2; ++ai)
#pragma unroll
                for (int m = 0; m < 4; ++m) { const int r = ai * HALF + wr * 64 + m * 16 + fr; const float rs = Rt[r]; const size_t off = (size_t)(u.pm * BM + r) * D + col0;
#pragma unroll
                    for (int bj = 0; bj < 2; ++bj) {
                        f32x4 o0, o1;
#pragma unroll
                        for (int j = 0; j < 4; ++j) { o0[j] = fmaf(acc[ai][bj][m][0][j] * rs, gq[bj][0][j], bq[bj][0][j]); o1[j] = fmaf(acc[ai][bj][m][1][j] * rs, gq[bj][1][j], bq[bj][1][j]); }
                        asm volatile("" : "+v"(o0), "+v"(o1));
                        if (h8) { _Pragma("unroll") for (int j = 0; j < 4; ++j) { o0[j] = __builtin_amdgcn_fmed3f(o0[j], -448.f, 448.f); o1[j] = __builtin_amdgcn_fmed3f(o1[j], -448.f, 448.f); }
                                  unsigned w0_ = 0u, w1_ = 0u; w0_ = __builtin_amdgcn_cvt_pk_fp8_f32(o0[0], o0[1], w0_, false); w0_ = __builtin_amdgcn_cvt_pk_fp8_f32(o0[2], o0[3], w0_, true);
                                  w1_ = __builtin_amdgcn_cvt_pk_fp8_f32(o1[0], o1[1], w1_, false); w1_ = __builtin_amdgcn_cvt_pk_fp8_f32(o1[2], o1[3], w1_, true);
                                  *(u32x2*)((unsigned char*)h + off + bj * HALF) = (u32x2){w0_, w1_}; }
                        else *(u32x4*)(h + off + bj * HALF) = (u32x4){pack2(o0[0], o0[1]), pack2(o0[2], o0[3]), pack2(o1[0], o1[1]), pack2(o1[2], o1[3])}; }
                    asm volatile("" ::: "memory"); }
        }
    }
};

template <class Epi, class Sched, bool ALIGN_EPI = true, bool SP2 = true, bool F8 = false>
__device__ __forceinline__ void gemm_phase(LAS unsigned char* lds, const Gemm g, const Sched& S, const Epi& E, int w0) {
    const int tid = phase_tid(w0), wid = __builtin_amdgcn_readfirstlane(tid >> 6), lane = tid & 63, wr = wid >> 2, wc = wid & 3, fr = lane & 15, fq = lane >> 4;
    const int K = g.K, nt = F8 ? K / 128 : K / BK; constexpr unsigned EB = F8 ? 1u : 2u;
    unsigned voffA[2], voffB[2];
#pragma unroll
    for (int i = 0; i < 2; ++i) { int R, C; stage_rc(tid * 16 + i * 8192, R, C); const int Rb = Epi::PERM ? ((R & ~31) + perm32(R & 31)) : R;
        voffA[i] = (unsigned)(R * K) * EB + (unsigned)C * 2u; voffB[i] = (unsigned)(Rb * K) * EB + (unsigned)C * 2u; }
    const size_t kstep = (size_t)(BK * 2);
    const size_t hstep = (size_t)HALF * K * EB;
    const size_t tstep = 2 * hstep;
    const unsigned ldsw = (unsigned)wid * 1024u;
    const int aoff = lds_byte(wr * 64 + fr, fq * 8), boff = lds_byte(wc * 32 + fr, fq * 8);
#define PG8_SA(b, h) (((b) * 2 + (h)) * HTB)
#define PG8_SB(b, h) ((4 + (b) * 2 + (h)) * HTB)
#define PG8_STAGE(bufoff, gbase, voff) do { _Pragma("unroll") for (int _i = 0; _i < 2; ++_i) \
        __builtin_amdgcn_global_load_lds((const unsigned*)((const char*)(gbase) + (voff)[_i]), (LAS unsigned*)(lds + (bufoff) + ldsw + _i * 8192), 16, 0, 0); } while (0)
#define PG8_LDA(dst, b, h) do { if constexpr (F8) { _Pragma("unroll") for (int m = 0; m < 4; ++m) { const u32x4 lo_ = *(const LAS u32x4*)(lds + PG8_SA(b, h) + aoff8_0 + m * 2048), hi_ = *(const LAS u32x4*)(lds + PG8_SA(b, h) + aoff8_0 + aoff8_1d + m * 2048); \
            dst##8[m] = __builtin_bit_cast(v8i_t, __builtin_shufflevector(lo_, hi_, 0, 1, 2, 3, 4, 5, 6, 7)); } } \
        else { _Pragma("unroll") for (int m = 0; m < 4; ++m) _Pragma("unroll") for (int k = 0; k < 2; ++k) dst[m][k] = *(const LAS f16x8*)(lds + PG8_SA(b, h) + aoff + m * 2048 + k * 1024); } } while (0)
#define PG8_LDB(dst, b, h) do { if constexpr (F8) { _Pragma("unroll") for (int n = 0; n < 2; ++n) { const u32x4 lo_ = *(const LAS u32x4*)(lds + PG8_SB(b, h) + boff8_0 + n * 2048), hi_ = *(const LAS u32x4*)(lds + PG8_SB(b, h) + boff8_0 + boff8_1d + n * 2048); \
            dst##8[n] = __builtin_bit_cast(v8i_t, __builtin_shufflevector(lo_, hi_, 0, 1, 2, 3, 4, 5, 6, 7)); } } \
        else { _Pragma("unroll") for (int n = 0; n < 2; ++n) _Pragma("unroll") for (int k = 0; k < 2; ++k) dst[n][k] = *(const LAS f16x8*)(lds + PG8_SB(b, h) + boff + n * 2048 + k * 1024); } } while (0)
#define PG8_MMA(ai, bj, At, Bt) do { __builtin_amdgcn_s_setprio(1); \
        if constexpr (F8) { _Pragma("unroll") for (int m = 0; m < 4; ++m) _Pragma("unroll") for (int n = 0; n < 2; ++n) \
            asm volatile("v_mfma_scale_f32_16x16x128_f8f6f4 %0, %1, %2, %0, %3, %4 op_sel_hi:[0,0,0]" : "+v"(acc[ai][bj][m][n]) : "v"(Bt##8[n]), "v"(At##8[m]), "v"(sc_w8), "v"(sc_a8)); } \
        else { _Pragma("unroll") for (int m = 0; m < 4; ++m) _Pragma("unroll") for (int n = 0; n < 2; ++n) _Pragma("unroll") for (int k = 0; k < 2; ++k) \
            acc[ai][bj][m][n] = __builtin_amdgcn_mfma_f32_16x16x32_f16(Bt[n][k], At[m][k], acc[ai][bj][m][n], 0, 0, 0); } \
        __builtin_amdgcn_s_setprio(0); } while (0)
#define PG8_WAIT_V(n) asm volatile("s_waitcnt vmcnt(" #n ")" ::: "memory")
#define PG8_WAIT_L(n) asm volatile("s_waitcnt lgkmcnt(" #n ")" ::: "memory")
#define PG8_BAR __builtin_amdgcn_s_barrier()
#define PG8_SCHED __builtin_amdgcn_sched_barrier(0)
    Unit cur, nxt; int ui = 0;
    if (!S.next(0, cur)) return;
    f32x4 acc[2][2][4][2];
#pragma unroll
    for (int a = 0; a < 2; ++a)
#pragma unroll
        for (int b = 0; b < 2; ++b)
#pragma unroll
            for (int m = 0; m < 4; ++m)
#pragma unroll
                for (int n = 0; n < 2; ++n) acc[a][b][m][n] = (f32x4){0.f, 0.f, 0.f, 0.f};
    f16x8 At[4][2], B0[2][2], B1[2][2];
    typedef int v8i_t __attribute__((ext_vector_type(8)));
    const int sc_w8 = g.wexp, sc_a8 = 127;
    v8i_t At8[4], B08[2], B18[2];
    const int aoff8_0 = lds_byte(wr * 64 + fr, (2 * (fq & 1)) * 8) + (fq >> 1) * 1024, boff8_0 = lds_byte(wc * 32 + fr, (2 * (fq & 1)) * 8) + (fq >> 1) * 1024;
    constexpr int aoff8_1d = 16, boff8_1d = 16;
    const char* cA = (const char*)g.A + (size_t)cur.pm * tstep; const char* cB = (const char*)g.Bt + (size_t)cur.pn * tstep;
    S.a_ready(cur);
    if constexpr (SP2) {
        PG8_STAGE(PG8_SB(0, 0), cB, voffB); PG8_STAGE(PG8_SB(0, 1), cB + hstep, voffB); PG8_STAGE(PG8_SA(0, 0), cA, voffA); PG8_STAGE(PG8_SA(0, 1), cA + hstep, voffA);
        if (wr == 1) PG8_BAR;
        PG8_WAIT_V(2); PG8_BAR;
        PG8_STAGE(PG8_SB(1, 0), cB + kstep, voffB); PG8_STAGE(PG8_SA(1, 0), cA + kstep, voffA); PG8_STAGE(PG8_SB(1, 1), cB + hstep + kstep, voffB);
        PG8_WAIT_V(6); PG8_BAR;
    } else {
        PG8_STAGE(PG8_SB(0, 0), cB, voffB); PG8_STAGE(PG8_SA(0, 0), cA, voffA); PG8_STAGE(PG8_SB(0, 1), cB + hstep, voffB); PG8_STAGE(PG8_SA(0, 1), cA + hstep, voffA);
        if (wr == 1) PG8_BAR;
        PG8_WAIT_V(4); PG8_BAR;
        PG8_STAGE(PG8_SB(1, 0), cB + kstep, voffB); PG8_STAGE(PG8_SA(1, 0), cA + kstep, voffA); PG8_STAGE(PG8_SB(1, 1), cB + hstep + kstep, voffB);
        PG8_WAIT_V(6); PG8_BAR;
    }
    for (;;) {
        const bool has_next = S.next(ui + 1, nxt);
        const char* nA = has_next ? (const char*)g.A + (size_t)nxt.pm * tstep : cA; const char* nB = has_next ? (const char*)g.Bt + (size_t)nxt.pn * tstep : cB;
        for (int t = 0; t < nt; t += 2) {
            const bool last = (t == nt - 2);
            const char* a1 = cA + (size_t)(t + 1) * kstep;
            const char* a2 = last ? nA : cA + (size_t)(t + 2) * kstep; const char* b2 = last ? nB : cB + (size_t)(t + 2) * kstep;
            const char* a3 = a2 + kstep; const char* b3 = b2 + kstep;
            if (last && has_next) S.a_ready(nxt);
            if constexpr (SP2) {
            PG8_LDB(B0, 0, 0); PG8_LDB(B1, 0, 1); PG8_SCHED; PG8_LDA(At, 0, 0); PG8_STAGE(PG8_SA(1, 1), a1 + hstep, voffA);
            PG8_WAIT_V(8); PG8_WAIT_L(0); PG8_BAR; PG8_MMA(0, 0, At, B0); PG8_MMA(0, 1, At, B1); PG8_BAR; PG8_SCHED;
            PG8_LDA(At, 0, 1); PG8_STAGE(PG8_SB(0, 0), b2, voffB); PG8_STAGE(PG8_SB(0, 1), b2 + hstep, voffB); PG8_STAGE(PG8_SA(0, 0), a2, voffA);
            PG8_WAIT_V(8); PG8_WAIT_L(0); PG8_BAR; PG8_MMA(1, 0, At, B0); PG8_MMA(1, 1, At, B1); PG8_BAR; PG8_SCHED;
            PG8_LDB(B0, 1, 0); PG8_LDB(B1, 1, 1); PG8_SCHED; PG8_LDA(At, 1, 0); PG8_STAGE(PG8_SA(0, 1), a2 + hstep, voffA);
            PG8_WAIT_V(8); PG8_WAIT_L(0); PG8_BAR; PG8_MMA(0, 0, At, B0); PG8_MMA(0, 1, At, B1); PG8_BAR; PG8_SCHED;
            PG8_LDA(At, 1, 1); PG8_STAGE(PG8_SB(1, 0), b3, voffB); PG8_STAGE(PG8_SB(1, 1), b3 + hstep, voffB); PG8_STAGE(PG8_SA(1, 0), a3, voffA);
            PG8_WAIT_V(8); PG8_WAIT_L(0); PG8_BAR; PG8_MMA(1, 0, At, B0); PG8_MMA(1, 1, At, B1); PG8_BAR; PG8_SCHED;
            } else {
            PG8_LDB(B0, 0, 0); PG8_SCHED; PG8_LDA(At, 0, 0); PG8_STAGE(PG8_SA(1, 1), a1 + hstep, voffA);
            PG8_WAIT_L(8); PG8_BAR; PG8_WAIT_L(0); PG8_MMA(0, 0, At, B0); PG8_BAR; PG8_SCHED;
            PG8_LDB(B1, 0, 1); PG8_STAGE(PG8_SB(0, 0), b2, voffB);
            PG8_BAR; PG8_WAIT_L(0); PG8_MMA(0, 1, At, B1); PG8_BAR;
            PG8_LDA(At, 0, 1); PG8_STAGE(PG8_SA(0, 0), a2, voffA);
            PG8_BAR; PG8_WAIT_L(0); PG8_MMA(1, 0, At, B0); PG8_BAR; PG8_SCHED;
            PG8_STAGE(PG8_SB(0, 1), b2 + hstep, voffB);
            PG8_WAIT_V(6); PG8_BAR; PG8_MMA(1, 1, At, B1); PG8_BAR;
            PG8_LDB(B0, 1, 0); PG8_SCHED; PG8_LDA(At, 1, 0); PG8_STAGE(PG8_SA(0, 1), a2 + hstep, voffA);
            PG8_WAIT_L(8); PG8_BAR; PG8_WAIT_L(0); PG8_MMA(0, 0, At, B0); PG8_BAR; PG8_SCHED;
            PG8_LDB(B1, 1, 1); PG8_STAGE(PG8_SB(1, 0), b3, voffB);
            PG8_BAR; PG8_WAIT_L(0); PG8_MMA(0, 1, At, B1); PG8_BAR;
            PG8_LDA(At, 1, 1); PG8_STAGE(PG8_SA(1, 0), a3, voffA);
            PG8_BAR; PG8_WAIT_L(0); PG8_MMA(1, 0, At, B0); PG8_BAR; PG8_SCHED;
            PG8_STAGE(PG8_SB(1, 1), b3 + hstep, voffB);
            PG8_WAIT_V(6); PG8_BAR; PG8_MMA(1, 1, At, B1); PG8_BAR;
            }
        }
        if constexpr (F8) asm volatile("s_nop 15\n\ts_nop 15" ::: "memory");
        if constexpr (ALIGN_EPI) { if (wr == 0) PG8_BAR; }
        if constexpr (!Epi::AFTER_DRAIN) { E(acc, cur, wr, wc, fr, fq); S.done(cur); }
        if (!has_next) break;
#pragma unroll
        for (int a = 0; a < 2; ++a)
#pragma unroll
            for (int b = 0; b < 2; ++b)
#pragma unroll
                for (int m = 0; m < 4; ++m)
#pragma unroll
                    for (int n = 0; n < 2; ++n) acc[a][b][m][n] = (f32x4){0.f, 0.f, 0.f, 0.f};
        cur = nxt; cA = nA; cB = nB; ++ui;
        if constexpr (ALIGN_EPI) { if (wr == 1) PG8_BAR; }
    }
    PG8_WAIT_V(0);
    if constexpr (!ALIGN_EPI) { if (wr == 0) PG8_BAR; }
    PG8_BAR;
    if constexpr (Epi::AFTER_DRAIN) { const int t2_ = phase_tid(w0), l2_ = t2_ & 63;
        E.fused(acc, cur, wr, wc, l2_ & 15, l2_ >> 4, lds, wid, l2_); S.done(cur); }
#undef PG8_SA
#undef PG8_SB
#undef PG8_STAGE
#undef PG8_LDA
#undef PG8_LDB
#undef PG8_MMA
#undef PG8_WAIT_V
#undef PG8_WAIT_L
#undef PG8_BAR
#undef PG8_SCHED
}
}
__device__ __forceinline__ int wave_sum_dpp(int v) {
    v += __builtin_amdgcn_update_dpp(0, v, 0xB1, 0xF, 0xF, false);
    v += __builtin_amdgcn_update_dpp(0, v, 0x4E, 0xF, 0xF, false);
    v += __builtin_amdgcn_update_dpp(0, v, 0x141, 0xF, 0xF, false);
    v += __builtin_amdgcn_update_dpp(0, v, 0x140, 0xF, 0xF, false);
    v += __builtin_amdgcn_update_dpp(0, v, 0x142, 0xA, 0xF, false);
    v += __builtin_amdgcn_update_dpp(0, v, 0x143, 0xC, 0xF, false);
    return __builtin_amdgcn_readlane(v, 63);
}
__device__ __forceinline__ uint32_t wave_max_dpp(uint32_t v) {
#define MX_(c, rm) { const uint32_t o_ = (uint32_t)__builtin_amdgcn_update_dpp(0, (int)v, c, rm, 0xF, false); v = o_ > v ? o_ : v; }
    MX_(0xB1, 0xF) MX_(0x4E, 0xF) MX_(0x141, 0xF) MX_(0x140, 0xF) MX_(0x142, 0xA) MX_(0x143, 0xC)
#undef MX_
    return (uint32_t)__builtin_amdgcn_readlane((int)v, 63);
}
__device__ __forceinline__ float wave_sum_f_dpp(float v) {
#define FS_(c, rm) v += __int_as_float(__builtin_amdgcn_update_dpp(0, __float_as_int(v), c, rm, 0xF, false));
    FS_(0xB1, 0xF) FS_(0x4E, 0xF) FS_(0x141, 0xF) FS_(0x140, 0xF) FS_(0x142, 0xA) FS_(0x143, 0xC)
#undef FS_
    return __int_as_float(__builtin_amdgcn_readlane(__float_as_int(v), 63));
}
__device__ __forceinline__ int wave_incl_scan_dpp(int v) {
    v += __builtin_amdgcn_update_dpp(0, v, 0x111, 0xF, 0xF, false);
    v += __builtin_amdgcn_update_dpp(0, v, 0x112, 0xF, 0xF, false);
    v += __builtin_amdgcn_update_dpp(0, v, 0x114, 0xF, 0xF, false);
    v += __builtin_amdgcn_update_dpp(0, v, 0x118, 0xF, 0xF, false);
    v += __builtin_amdgcn_update_dpp(0, v, 0x142, 0xA, 0xF, false);
    v += __builtin_amdgcn_update_dpp(0, v, 0x143, 0xC, 0xF, false);
    return v;
}
__device__ __forceinline__ void cnt4(int& acc, uint32_t cand, uint32_t k0, uint32_t k1, uint32_t k2, uint32_t k3) {
    unsigned long long m1, m2, m3;
    asm("v_cmp_le_u32_e64 vcc, %4, %5\n\tv_cmp_le_u32_e64 %1, %4, %6\n\tv_cmp_le_u32_e64 %2, %4, %7\n\tv_cmp_le_u32_e64 %3, %4, %8\n\t"
        "v_addc_co_u32_e64 %0, vcc, 0, %0, vcc\n\tv_addc_co_u32_e64 %0, %1, 0, %0, %1\n\tv_addc_co_u32_e64 %0, %2, 0, %0, %2\n\tv_addc_co_u32_e64 %0, %3, 0, %0, %3"
        : "+v"(acc), "=&s"(m1), "=&s"(m2), "=&s"(m3) : "s"(cand), "v"(k0), "v"(k1), "v"(k2), "v"(k3) : "vcc");
}
__device__ __forceinline__ void cnt2(int& acc, uint32_t cand, uint32_t k0, uint32_t k1) {
    unsigned long long m1;
    asm("v_cmp_le_u32_e64 vcc, %2, %3\n\tv_cmp_le_u32_e64 %1, %2, %4\n\ts_nop 0\n\t"
        "v_addc_co_u32_e64 %0, vcc, 0, %0, vcc\n\tv_addc_co_u32_e64 %0, %1, 0, %0, %1"
        : "+v"(acc), "=&s"(m1) : "s"(cand), "v"(k0), "v"(k1) : "vcc");
}
__device__ __forceinline__ void cnt4f(int& acc, uint32_t g, uint32_t k0, uint32_t k1, uint32_t k2, uint32_t k3) {
    unsigned long long m1, m2, m3;
    asm("v_cmp_le_f32_e64 vcc, %4, %5\n\tv_cmp_le_f32_e64 %1, %4, %6\n\tv_cmp_le_f32_e64 %2, %4, %7\n\tv_cmp_le_f32_e64 %3, %4, %8\n\t"
        "v_addc_co_u32_e64 %0, vcc, 0, %0, vcc\n\tv_addc_co_u32_e64 %0, %1, 0, %0, %1\n\tv_addc_co_u32_e64 %0, %2, 0, %0, %2\n\tv_addc_co_u32_e64 %0, %3, 0, %0, %3"
        : "+v"(acc), "=&s"(m1), "=&s"(m2), "=&s"(m3) : "s"(g), "v"(k0), "v"(k1), "v"(k2), "v"(k3) : "vcc");
}
__device__ __forceinline__ uint32_t okey(uint32_t u) { return u ^ ((uint32_t)((int)u >> 31) | 0x80000000u); }
__device__ __forceinline__ uint32_t okey_inv(uint32_t k) { return k ^ ((uint32_t)(~(int)k >> 31) | 0x80000000u); }
constexpr uint32_t SEL_NAN = 0x7FC00000u;
constexpr int SEL_CAP = 1024, SEL_WLDS = (SEL_CAP + 64) * 8 + 1024;

#define SEL_LOAD(t_) do { const int sm_ = (t_) >> 6, sodd_ = ((t_) >> 5) & 1;        \
        const float* row_ = S + (size_t)__builtin_amdgcn_readfirstlane((sodd_ ? (sm_ + 1) * (sm_ + 1) : sm_ * (sm_ + 1)) * 2048 + ((t_) & 31) * 64);     \
        const __amdgpu_buffer_rsrc_t rs_ = __builtin_amdgcn_make_buffer_rsrc((void*)row_, (short)0, (int)0x7FFFFFFF, 0x00020000);     \
        const int NGl_ = (t_) < TOPK ? 0 : ((t_) >> 10) + 1;                                                                 \
        _Pragma("unroll") for (int g = 0; g < 8; ++g) {                                                                    \
            if (g < NGl_) { _Pragma("unroll") for (int j = 0; j < 16; ++j) key[g * 16 + j] = __builtin_amdgcn_raw_buffer_load_b32(rs_, lane4, (g * 16 + j) * 8192, 0); }   \
            else { _Pragma("unroll") for (int j = 0; j < 16; ++j) key[g * 16 + j] = 0u; } } } while (0)
#define PIN16K(b) asm volatile("" : "+v"(key[(b)+0]), "+v"(key[(b)+1]), "+v"(key[(b)+2]), "+v"(key[(b)+3]), "+v"(key[(b)+4]), "+v"(key[(b)+5]), "+v"(key[(b)+6]), "+v"(key[(b)+7]), \
                                   "+v"(key[(b)+8]), "+v"(key[(b)+9]), "+v"(key[(b)+10]), "+v"(key[(b)+11]), "+v"(key[(b)+12]), "+v"(key[(b)+13]), "+v"(key[(b)+14]), "+v"(key[(b)+15]))
#define SEL_PIN() do { PIN16K(0); PIN16K(16); PIN16K(32); PIN16K(48); PIN16K(64); PIN16K(80); PIN16K(96); PIN16K(112); } while (0)

__device__ __forceinline__ uint32_t sel_thr(uint32_t cand) { return cand <= 0x007FFFFFu ? 0xFF800000u : okey_inv(cand); }
__device__ __forceinline__ void sel_full(const uint32_t (&key)[128], int NG, int lane, unsigned long long& wlo, unsigned long long& whi) {
    uint32_t prefix = 0u; bool exact = false;
    for (int bit = 31; bit >= 0; --bit) {
        const uint32_t cand = prefix | (1u << bit); const uint32_t gf = sel_thr(cand);
        int cl = 0;
#pragma unroll
        for (int g = 0; g < 8; ++g) {
            if (g < NG) {
#pragma unroll
                for (int j = 0; j < 16; j += 4) cnt4f(cl, gf, key[g * 16 + j], key[g * 16 + j + 1], key[g * 16 + j + 2], key[g * 16 + j + 3]);
            }
        }
        const int cnt = wave_sum_dpp(cl);
        if (cnt >= TOPK) prefix = cand;
        if (cnt == TOPK) { exact = true; break; }
    }
    const float tf = __uint_as_float(sel_thr(prefix));
    wlo = 0ull; whi = 0ull;
    if (exact) {
#pragma unroll
        for (int i = 0; i < 128; ++i) {
            const unsigned long long b = ((i >> 4) < NG) ? __ballot(tf <= __uint_as_float(key[i])) : 0ull;
            if (i < 64) { if (lane == i) wlo = b; } else { if (lane == i - 64) whi = b; }
        }
    } else {
        int cl = 0;
#pragma unroll
        for (int i = 0; i < 128; ++i) cl += ((i >> 4) < NG && tf < __uint_as_float(key[i])) ? 1 : 0;
        cl = wave_sum_dpp(cl);
        int need = TOPK - cl;
        const unsigned long long lt = (lane == 0) ? 0ull : ((~0ull) >> (64 - lane));
        float tf1 = tf; asm volatile("" : "+v"(tf1));
#pragma unroll
        for (int i = 0; i < 128; ++i) {
            const bool ing = (i >> 4) < NG; const float fi = __uint_as_float(key[i]);
            const unsigned long long eq = ing ? __ballot(fi == tf1) : 0ull;
            const int rank = __popcll(eq & lt);
            const bool sel = ing && ((tf1 < fi) || (fi == tf1 && rank < need));
            need -= __popcll(eq); if (need < 0) need = 0;
            const unsigned long long b = __ballot(sel);
            if (i < 64) { if (lane == i) wlo = b; } else { if (lane == i - 64) whi = b; }
        }
    }
}

__device__ __forceinline__ void select_phase(int blk, const float* __restrict__ S, unsigned long long* __restrict__ mask, LAS unsigned char* lds, int w0, f16* poison = nullptr) {
    const int tid = phase_tid(w0), lane = tid & 63, g8 = __builtin_amdgcn_readfirstlane(tid >> 6), gq = blk * 8 + g8;
    LAS unsigned char* wl = lds + g8 * SEL_WLDS;
    LAS uint32_t* prl = (LAS uint32_t*)wl; LAS uint32_t* pil = (LAS uint32_t*)(wl + (SEL_CAP + 64) * 4); LAS uint32_t* rowb = (LAS uint32_t*)(wl + (SEL_CAP + 64) * 8);
    (void)poison;
    uint32_t key[128];
    const int lane4 = lane * 4;
    SEL_LOAD(gq);
#pragma unroll 1
    for (int k = 0; k < 4; ++k) {
        const int t = (k == 0) ? gq : (k == 1) ? 4095 - gq : (k == 2) ? 4096 + gq : 8191 - gq;
        const int tn = (k == 0) ? 4095 - gq : (k == 1) ? 4096 + gq : 8191 - gq;
        unsigned long long* mrow = mask + (size_t)t * 128;
        if (t < TOPK) {
            for (int i = lane; i < 128; i += 64) {
                const int lo = i * 64; unsigned long long w = 0ull;
                if (t >= lo + 63) w = ~0ull; else if (t >= lo) w = (~0ull) >> (63 - (t - lo));
                mrow[i] = w;
            }
            SEL_LOAD(tn);
            continue;
        }
        const int NG = (t >> 10) + 1;
        int lane_k = lane; asm volatile("" : "+v"(lane_k));
        SEL_PIN();
#pragma unroll
        for (int g = 0; g < 8; ++g) {
            if (g == NG - 1) {
#pragma unroll
                for (int j = 0; j < 16; ++j) { const int idx = (g * 16 + j) * 64 + lane_k; key[g * 16 + j] = idx <= t ? key[g * 16 + j] : SEL_NAN; }
            }
        }
        uint32_t G = 0xFF800000u;
        int cg = 0, incl = 0, C = 0; bool fast = false;
#pragma unroll 1
        for (int att = 0; att < 2; ++att) {
            if (NG >= 2) {
                if (att == 0) {
                    float s1 = 0.f, s2 = 0.f; int n = 0;
#pragma unroll
                    for (int g = 0; g < 8; ++g) {
                        if (g < NG) {
#pragma unroll
                            for (int r = 4; r < 16; r += 8) { const float fr = __uint_as_float(key[16 * g + r]); const bool ok = fr == fr;
                                const float fv = ok ? fr : 0.f; s1 += fv; s2 = fmaf(fv, fv, s2); n += ok ? 1 : 0; }
                        }
                    }
                    const float S1 = wave_sum_f_dpp(s1), S2 = wave_sum_f_dpp(s2); const float N = (float)wave_sum_dpp(n);
                    const float mean = S1 / N, var = S2 / N - mean * mean, sd = __builtin_sqrtf(fmaxf(var, 0.f));
                    float p = 80.f / N; const bool up = p <= 0.5f; p = up ? p : 1.f - p; p = fmaxf(p, 1e-6f);
                    const float tt = __builtin_sqrtf(-2.f * __logf(p));
                    float z = tt - (2.515517f + tt * (0.802853f + tt * 0.010328f)) / (1.f + tt * (1.432788f + tt * (0.189269f + tt * 0.001308f)));
                    z = up ? z : -z;
                    const float gf = mean + z * sd;
                    G = __builtin_amdgcn_readfirstlane(__float_as_uint(gf));
                } else {
                    uint32_t sk[16];
#pragma unroll
                    for (int g = 0; g < 8; ++g) {
#pragma unroll
                        for (int r = 0; r < 2; ++r) { const uint32_t u = key[16 * g + 4 + 8 * r]; sk[2 * g + r] = (g < NG && __uint_as_float(u) == __uint_as_float(u)) ? okey(u) : 0u; }
                    }
                    uint32_t pre = 0u;
                    for (int bit = 31; bit >= 12; --bit) {
                        const uint32_t cand = pre | (1u << bit);
                        int cl = 0;
#pragma unroll
                        for (int m = 0; m < 16; m += 4) cnt4(cl, cand, sk[m], sk[m + 1], sk[m + 2], sk[m + 3]);
                        const int cnt = wave_sum_dpp(cl);
                        if (cnt >= 80) pre = cand;
                        if (cnt == 80) break;
                    }
                    G = pre ? okey_inv(pre) : SEL_NAN;
                }
            }
            cg = 0;
#pragma unroll
            for (int g = 0; g < 8; ++g) {
                if (g < NG) {
#pragma unroll
                    for (int j = 0; j < 16; j += 4) cnt4f(cg, G, key[g * 16 + j], key[g * 16 + j + 1], key[g * 16 + j + 2], key[g * 16 + j + 3]);
                }
            }
            incl = wave_incl_scan_dpp(cg);
            C = __builtin_amdgcn_readlane(incl, 63);
            fast = (C >= TOPK) && (C <= SEL_CAP);
            if (fast || NG < 2) break;
        }
        if (!fast) {
            unsigned long long wlo, whi; sel_full(key, NG, lane_k, wlo, whi);
            mrow[lane_k] = wlo; mrow[64 + lane_k] = whi;
        } else {
            int lane_c = lane_k; asm volatile("" : "+v"(lane_c));
            int pos = incl - cg; const int trash = SEL_CAP + lane_c;
            uint32_t G2 = G; asm volatile("" : "+s"(G2));
#pragma unroll
            for (int g = 0; g < 8; ++g) {
                if (g < NG) {
#pragma unroll
                    for (int j = 0; j < 16; ++j) {
                        const int i = g * 16 + j; const bool p = __uint_as_float(G2) <= __uint_as_float(key[i]);
                        const int a = p ? pos : trash;
                        prl[a] = key[i]; pil[a] = (unsigned)(i * 64 + lane_c);
                        pos += p ? 1 : 0;
                    }
                }
            }
        }
#ifdef SEL_CHECK
        unsigned chk_h = 0u;
        if (fast) { unsigned long long chk_lo = 0ull, chk_hi = 0ull; sel_full(key, NG, lane_k, chk_lo, chk_hi); chk_h = (unsigned)chk_lo * 3u + (unsigned)(chk_lo >> 32) * 5u + (unsigned)chk_hi * 7u + (unsigned)(chk_hi >> 32) * 11u; }
#endif
        if (k < 3) SEL_LOAD(tn);
        if (fast) {
            int lane_s = lane; asm volatile("" : "+v"(lane_s));
            { unsigned z0 = 0u; asm volatile("" : "+v"(z0)); *(LAS u32x4*)(rowb + lane_s * 4) = u32x4{z0, z0, z0, z0}; }
            asm volatile("" ::: "memory");
            uint32_t ck[16], ci[16];
#pragma unroll
            for (int j = 0; j < 16; ++j) { const int p = j * 64 + lane_s; const uint32_t v = prl[p]; ck[j] = p < C ? okey(v) : 0u; ci[j] = pil[p]; }
            uint32_t mx = ck[0], mn = ck[0] ? ck[0] : 0xFFFFFFFFu;
#pragma unroll
            for (int j = 1; j < 16; ++j) { mx = ck[j] > mx ? ck[j] : mx; const uint32_t kz = ck[j] ? ck[j] : 0xFFFFFFFFu; mn = kz < mn ? kz : mn; }
            mx = wave_max_dpp(mx); mn = ~wave_max_dpp(~mn);
            const uint32_t dx = mn ^ mx;
            uint32_t prefix = mn; int hb = -1;
            if (dx != 0u) { hb = 31 - __builtin_clz(dx); prefix = (hb == 31) ? 0u : (mn & ~((2u << hb) - 1u)); }
            for (int bit = hb; bit >= 0; --bit) {
                const uint32_t cand = prefix | (1u << bit);
                int c0 = 0, c1 = 0, c2 = 0, c3 = 0;
                cnt4(c0, cand, ck[0], ck[1], ck[2], ck[3]); cnt4(c1, cand, ck[4], ck[5], ck[6], ck[7]); cnt4(c2, cand, ck[8], ck[9], ck[10], ck[11]); cnt4(c3, cand, ck[12], ck[13], ck[14], ck[15]);
                const int cnt = wave_sum_dpp((c0 + c1) + (c2 + c3));
                if (cnt >= TOPK) prefix = cand;
                if (cnt == TOPK) break;
            }
            const uint32_t T = prefix;
            int c_ge = 0, c_gt = 0;
#pragma unroll
            for (int j = 0; j < 16; ++j) { c_ge += (ck[j] >= T) ? 1 : 0; c_gt += (ck[j] > T) ? 1 : 0; }
            c_ge = wave_sum_dpp(c_ge);
            uint32_t Q = 0xFFFFFFFFu;
            if (c_ge != TOPK) {
                const int need = TOPK - wave_sum_dpp(c_gt);
                Q = 0u;
                for (int bit = 12; bit >= 0; --bit) {
                    const uint32_t cand = Q | (1u << bit);
                    int cl = 0;
#pragma unroll
                    for (int j = 0; j < 16; ++j) cl += (ck[j] == T && ci[j] < cand) ? 1 : 0;
                    if (wave_sum_dpp(cl) < need) Q = cand;
                }
            }
#pragma unroll
            for (int j = 0; j < 16; ++j) {
                const bool sel = (ck[j] > T) || (ck[j] == T && ci[j] <= Q);
                if (sel) __hip_atomic_fetch_or(rowb + (ci[j] >> 5), 1u << (ci[j] & 31), __ATOMIC_RELAXED, __HIP_MEMORY_SCOPE_WORKGROUP);
            }
            asm volatile("" ::: "memory");
            const LAS unsigned long long* rb64 = (const LAS unsigned long long*)rowb;
            const unsigned long long wlo_ = rb64[lane_s], whi_ = rb64[64 + lane_s];
#ifdef SEL_CHECK
            if (chk_h != (unsigned)wlo_ * 3u + (unsigned)(wlo_ >> 32) * 5u + (unsigned)whi_ * 7u + (unsigned)(whi_ >> 32) * 11u) poison[lane_s] = (f16)__builtin_nanf("");
#endif
            mrow[lane_s] = wlo_; mrow[64 + lane_s] = whi_;
        }
    }
}
#undef SEL_LOAD
#undef SEL_PIN
#undef PIN16K
constexpr int IDX_UNITS = 16512;
constexpr int IDX_QPITCH = 2320;
constexpr int IDX_TPITCH = 272;
constexpr int IDX_WOFF = 32 * IDX_QPITCH + 8 * 32 * IDX_TPITCH;
constexpr int IDX_LDS = IDX_WOFF + 2048;
__device__ __forceinline__ void idx_unit_decode(int u, int& strip, int& tile) {
    int m = (int)((sqrtf(4.0f * (float)u + 1.0f) - 1.0f) * 0.5f);
    while (m * (m + 1) > u) --m;
    while ((m + 1) * (m + 2) <= u) ++m;
    if (u < (m + 1) * (m + 1)) { strip = 2 * m; tile = u - m * (m + 1); } else { strip = 2 * m + 1; tile = u - (m + 1) * (m + 1); }
}
__device__ __forceinline__ float relu_asm(float x) { return __builtin_amdgcn_fmed3f(x, 0.f, __builtin_inff()); }
__device__ __forceinline__ void idx_phase(int blk, const f16* __restrict__ qi, const f16* __restrict__ ki, const float* __restrict__ wi, float* __restrict__ S, LAS unsigned char* lds, int w0) {
    const int tid = phase_tid(w0), wid = __builtin_amdgcn_readfirstlane(tid >> 6), lane = tid & 63, ql = lane & 31, kh = lane >> 5;
    LAS unsigned char* qs = lds;
    LAS unsigned char* tb = lds + 32 * IDX_QPITCH + wid * (32 * IDX_TPITCH);
    constexpr int IDX_ROUNDS = 2176;
    const int cu0 = blk <= 224 ? blk * 79 : 224 * 79 + (blk - 224) * 127, cu1 = (blk + 1) <= 224 ? (blk + 1) * 79 : 224 * 79 + (blk + 1 - 224) * 127;
    const int rlo = cu0 / 10, rhi = cu1 / 10;
    int rr = rlo;
    while (rr < rhi) {
        int q = (int)((sqrtf(0.5f * (float)rr + 1.0f) - 1.0f) * 0.5f);
        while (8 * q * (q + 1) > rr) --q;
        while (8 * (q + 1) * (q + 2) <= rr) ++q;
        const int rem = rr - 8 * q * (q + 1), strip = 16 * q + rem / (q + 1), j0 = rem % (q + 1);
        const int ntile = (strip >> 1) + 1;
        int jn = q + 1 - j0; if (jn > rhi - rr) jn = rhi - rr;
        const int tile0 = 8 * j0; int n = 8 * (j0 + jn); if (n > ntile) n = ntile; n -= tile0;
        const int sm = strip >> 1, u = ((strip & 1) ? (sm + 1) * (sm + 1) : sm * (sm + 1)) + tile0;
        const int t0 = strip * 32;
        __syncthreads();
#pragma unroll
        for (int i = 0; i < 8; ++i) { const int idx = tid + 512 * i, r = idx >> 7, c = (idx & 127) * 8;
            const u32x4 v = *(const u32x4*)(qi + (size_t)(t0 + r) * 1024 + c);
            *(LAS u32x4*)(qs + r * IDX_QPITCH + c * 2) = v; }
        if (tid < 128) { const int r = tid >> 2, c = (tid & 3) * 4; *(LAS f32x4*)(lds + IDX_WOFF + (r * 16 + c) * 4) = *(const f32x4*)(wi + (size_t)(t0 + r) * 16 + c); }
        __syncthreads();
        { const int r = tid >> 4, sg = (tid & 15) * 4; float a0 = 0.f, a1 = 0.f, a2 = 0.f, a3 = 0.f;
#pragma unroll
          for (int h = 0; h < 16; ++h) { const f16x4 q4 = *(const LAS f16x4*)(qs + r * IDX_QPITCH + (h * 64 + sg) * 2); const float wv = ((const LAS float*)(lds + IDX_WOFF))[r * 16 + h];
              a0 = fmaf((float)q4[0], wv, a0); a1 = fmaf((float)q4[1], wv, a1); a2 = fmaf((float)q4[2], wv, a2); a3 = fmaf((float)q4[3], wv, a3); }
          const f16 h0 = (f16)a0, h1 = (f16)a1, h2 = (f16)a2, h3 = (f16)a3;
          *(LAS f16x4*)(qs + r * IDX_QPITCH + 2048 + sg * 2) = (f16x4){h0, h1, h2, h3};
          *(LAS f16x4*)(qs + r * IDX_QPITCH + 2176 + sg * 2) = (f16x4){(f16)(a0 - (float)h0), (f16)(a1 - (float)h1), (f16)(a2 - (float)h2), (f16)(a3 - (float)h3)}; }
        __syncthreads();
        f16x8 kn[2][4];
#define IDX_LDK(dst, kbase) do { _Pragma("unroll") for (int kb = 0; kb < 2; ++kb) _Pragma("unroll") for (int kk = 0; kk < 4; ++kk) \
            dst[kb][kk] = *(const f16x8*)(ki + (size_t)((kbase) + kb * 32 + ql) * 64 + kk * 16 + kh * 8); } while (0)
        if (wid < n) IDX_LDK(kn, (tile0 + wid) * 64);
        for (int tl = wid; tl < n; tl += 8) {
            const int k0 = (tile0 + tl) * 64;
            f16x8 ka[2][4];
#pragma unroll
            for (int kb = 0; kb < 2; ++kb)
#pragma unroll
                for (int kk = 0; kk < 4; ++kk) ka[kb][kk] = kn[kb][kk];
            { const int tn = (tl + 8 < n) ? tl + 8 : tl; IDX_LDK(kn, (tile0 + tn) * 64); }
            f32x16 sc0 = {}, sc1 = {};
            const LAS unsigned char* qrow = qs + ql * IDX_QPITCH + kh * 16;
            const LAS float* wrow = (const LAS float*)(lds + IDX_WOFF) + ql * 16;
            f16x8 qbA[4], qbB[4];
#define IDX_LDQ(dst, off) do { _Pragma("unroll") for (int kk = 0; kk < 4; ++kk) dst[kk] = *(const LAS f16x8*)(qrow + (off) + kk * 32); } while (0)
#define IDX_HEAD(qb, D0, D1) do { D0 = f32x16{}; D1 = f32x16{}; \
                _Pragma("unroll") for (int kk = 0; kk < 4; ++kk) { D0 = __builtin_amdgcn_mfma_f32_32x32x16_f16(ka[0][kk], qb[kk], D0, 0, 0, 0); D1 = __builtin_amdgcn_mfma_f32_32x32x16_f16(ka[1][kk], qb[kk], D1, 0, 0, 0); } } while (0)
#define IDX_ACC(D0, D1, wh) do { _Pragma("unroll") for (int r = 0; r < 16; ++r) { float a0_ = fmaf(__builtin_fabsf(D0[r]), (wh), sc0[r]); asm("" : "+v"(a0_)); sc0[r] = a0_;     \
                float a1_ = fmaf(__builtin_fabsf(D1[r]), (wh), sc1[r]); asm("" : "+v"(a1_)); sc1[r] = a1_; } } while (0)
            f32x16 dA0, dA1, dB0, dB1;
            IDX_LDQ(qbA, 0);
            IDX_HEAD(qbA, dA0, dA1);
#pragma unroll 1
            for (int h = 0; h < 14; h += 2) {
                IDX_LDQ(qbB, (h + 1) * 128);
                { const float wh = wrow[h]; IDX_HEAD(qbB, dB0, dB1); IDX_ACC(dA0, dA1, wh); }
                __builtin_amdgcn_sched_barrier(0);
                IDX_LDQ(qbA, (h + 2) * 128);
                { const float wh = wrow[h + 1]; IDX_HEAD(qbA, dA0, dA1); IDX_ACC(dB0, dB1, wh); }
                __builtin_amdgcn_sched_barrier(0);
            }
            IDX_LDQ(qbB, 15 * 128);
            { const float wh = wrow[14]; IDX_HEAD(qbB, dB0, dB1); IDX_ACC(dA0, dA1, wh); }
            __builtin_amdgcn_sched_barrier(0);
            IDX_LDQ(qbA, 2048);
            { const float wh = wrow[15]; IDX_ACC(dB0, dB1, wh); }
#pragma unroll
            for (int kk = 0; kk < 4; ++kk) { sc0 = __builtin_amdgcn_mfma_f32_32x32x16_f16(ka[0][kk], qbA[kk], sc0, 0, 0, 0); sc1 = __builtin_amdgcn_mfma_f32_32x32x16_f16(ka[1][kk], qbA[kk], sc1, 0, 0, 0); }
#undef IDX_LDQ
#undef IDX_HEAD
#undef IDX_ACC
#pragma unroll
            for (int g = 0; g < 4; ++g) {
                *(LAS f32x4*)(tb + ql * IDX_TPITCH + (8 * g + 4 * kh) * 4) = (f32x4){sc0[4 * g] * 0.015625f, sc0[4 * g + 1] * 0.015625f, sc0[4 * g + 2] * 0.015625f, sc0[4 * g + 3] * 0.015625f};
                *(LAS f32x4*)(tb + ql * IDX_TPITCH + (32 + 8 * g + 4 * kh) * 4) = (f32x4){sc1[4 * g] * 0.015625f, sc1[4 * g + 1] * 0.015625f, sc1[4 * g + 2] * 0.015625f, sc1[4 * g + 3] * 0.015625f};
            }
            asm volatile("s_waitcnt lgkmcnt(0)" ::: "memory");
#pragma unroll
            for (int i = 0; i < 8; ++i) { const int r = i * 4 + (lane >> 4), c = (lane & 15) * 4;
                const f32x4 v = *(const LAS f32x4*)(tb + r * IDX_TPITCH + c * 4);
                __builtin_nontemporal_store(v, (f32x4*)(S + (size_t)(u + tl) * 2048 + r * 64 + c)); }
            asm volatile("s_waitcnt lgkmcnt(0)" ::: "memory");
        }
#undef IDX_LDK
        rr += jn;
    }
}
namespace att {
constexpr int NW = 8, QBLK = 32, KVBLK = 64, QB = NW * QBLK;
constexpr int SHM_V = KVBLK * HD * 2, SHM_K = KVBLK * HD * 2;
constexpr int OFF_WS = 2 * SHM_V + 2 * SHM_K, OFF_DT = OFF_WS + NW * 64 * 4, OFF_V2 = OFF_DT + 1280, LDS_BYTES = OFF_V2 + SHM_V;
constexpr float SCALE = 0.08838834764831845f, THR = 8.f;
#define KSWZ(row, colB) ((row) * 256 + ((colB) ^ (((row) & 7) << 4)))
#define SBAR() __builtin_amdgcn_sched_barrier(0)
__device__ __forceinline__ int v_st(int k, int c) { const int kk = (k & ~0xC) | ((k & 4) << 1) | ((k & 8) >> 1); return ((kk >> 3) * 4 + (c >> 5)) * 512 + ((kk & 7) * 32 + (c & 31)) * 2; }
__device__ __forceinline__ int v_rd_base(int lane) { return ((lane & 3) << 3) | (((lane >> 2) & 3) << 6) | (((lane >> 4) & 1) << 5) | (((lane >> 5) & 1) << 8); }
constexpr int v_rd_off(int d0, int ks, int half) { return d0 * 512 + ks * 4096 + half * 2048; }
__device__ __forceinline__ int crow(int r, int hi) { return (r & 3) + 8 * (r >> 2) + 4 * hi; }
__device__ __forceinline__ __amdgpu_buffer_rsrc_t mkrsrc(const void* p, unsigned bytes) {
    const unsigned long long a = (unsigned long long)p; const unsigned lo = __builtin_amdgcn_readfirstlane((unsigned)a), hi = __builtin_amdgcn_readfirstlane((unsigned)(a >> 32));
    return __builtin_amdgcn_make_buffer_rsrc((void*)(((unsigned long long)hi << 32) | lo), (short)0, (int)bytes, 0x00020000); }
__device__ __forceinline__ f16x8 bld8(__amdgpu_buffer_rsrc_t r, unsigned voff, unsigned soff) { u32x4 v = __builtin_amdgcn_raw_buffer_load_b128(r, voff, soff, 0); return *reinterpret_cast<f16x8*>(&v); }
#define FMASK1(P, W, r, b) do { int m_; asm("v_bfe_i32 %0, %1, " #b ", 1" : "=v"(m_) : "v"(W)); P[r] = __uint_as_float(__float_as_uint(P[r]) & (unsigned)m_); } while (0)
#define FMASK16(P, W) do { FMASK1(P, W, 0, 0); FMASK1(P, W, 1, 1); FMASK1(P, W, 2, 2); FMASK1(P, W, 3, 3); FMASK1(P, W, 4, 8); FMASK1(P, W, 5, 9); FMASK1(P, W, 6, 10); FMASK1(P, W, 7, 11); \
    FMASK1(P, W, 8, 16); FMASK1(P, W, 9, 17); FMASK1(P, W, 10, 18); FMASK1(P, W, 11, 19); FMASK1(P, W, 12, 24); FMASK1(P, W, 13, 25); FMASK1(P, W, 14, 26); FMASK1(P, W, 15, 27); } while (0)
__device__ __forceinline__ void bias_tile(f32x16& p0, f32x16& p1, int dq, const float* dtab) {
    const float* bp = dtab + (dq + 96 - 59);
#pragma unroll
    for (int r = 0; r < 16; ++r) {
        const int c = (r & 3) + 8 * (r >> 2);
        p0[r] += bp[59 - c];
        p1[r] += bp[27 - c];
    }
}
__device__ __forceinline__ void partialSM(f32x16& p0, f32x16& p1, float& m_reg, float& mn, float& alpha, unsigned mlo) {
    float pmax = p0[0];
_Pragma("unroll") for (int r = 1; r < 16; ++r) pmax = fmaxf(pmax, p0[r]);
_Pragma("unroll") for (int r = 0; r < 16; ++r) pmax = fmaxf(pmax, p1[r]);
    { auto rr = __builtin_amdgcn_permlane32_swap(__float_as_uint(pmax), __float_as_uint(pmax), false, false);
      pmax = fmaxf(__uint_as_float(rr[0]), __uint_as_float(rr[1])); }
    constexpr float C2 = 1.4426950408889634f * SCALE;
    if (__builtin_expect(__all((pmax - m_reg) * SCALE <= THR), 1)) { mn = m_reg; alpha = 1.f; }
    else { mn = fmaxf(m_reg, pmax); alpha = __builtin_amdgcn_exp2f((m_reg - mn) * C2); m_reg = mn; }
    const float mnL = -mn * C2;
_Pragma("unroll") for (int r = 0; r < 16; ++r) p0[r] = fmaf(p0[r], C2, mnL);
_Pragma("unroll") for (int r = 0; r < 16; ++r) p1[r] = fmaf(p1[r], C2, mnL);
_Pragma("unroll") for (int r = 0; r < 16; ++r) p0[r] = __builtin_amdgcn_exp2f(p0[r]);
    FMASK16(p0, mlo);
}
__device__ __forceinline__ void finishSM(f32x16& p0, f32x16& p1, float alpha, float& l_reg, f16x8& pa0, f16x8& pa1, f16x8& pa2, f16x8& pa3, unsigned mhi) {
_Pragma("unroll") for (int r = 0; r < 16; ++r) p1[r] = __builtin_amdgcn_exp2f(p1[r]);
    FMASK16(p1, mhi);
    float ps = 0;
_Pragma("unroll") for (int r = 0; r < 16; ++r) ps += p0[r];
_Pragma("unroll") for (int r = 0; r < 16; ++r) ps += p1[r];
    { auto rr = __builtin_amdgcn_permlane32_swap(__float_as_uint(ps), __float_as_uint(ps), false, false);
      ps = __uint_as_float(rr[0]) + __uint_as_float(rr[1]); }
    l_reg = l_reg * alpha + ps;
#define PK4(P, B_, OUT) do { unsigned a0 = pack2(P[B_+0], P[B_+1]), a1 = pack2(P[B_+2], P[B_+3]);                          \
        unsigned b0 = pack2(P[B_+4], P[B_+5]), b1 = pack2(P[B_+6], P[B_+7]);                                             \
        auto r0 = __builtin_amdgcn_permlane32_swap(a0, b0, false, false); auto r1 = __builtin_amdgcn_permlane32_swap(a1, b1, false, false); \
        u32x4 w = {r0[0], r1[0], r0[1], r1[1]}; OUT = *reinterpret_cast<f16x8*>(&w); } while (0)
    PK4(p0, 0, pa0); PK4(p0, 8, pa1); PK4(p1, 0, pa2); PK4(p1, 8, pa3);
#undef PK4
}
template <int KB>
__device__ __forceinline__ void qkt(f32x16& p0, f32x16& p1, const char* K_lds, int r32, int hi, const f16x8* qr) {
    p0 = f32x16{}; p1 = f32x16{};
    const char* kb[4];
#pragma unroll
    for (int dd = 0; dd < 4; ++dd) kb[dd] = K_lds + KB * SHM_K + KSWZ(r32, (dd * 16 + hi * 8) * 2);
#pragma unroll
    for (int d0 = 0; d0 < 8; ++d0) { const char* a = kb[d0 & 3] + (d0 >> 2) * 128;
        f16x8 b0 = *reinterpret_cast<const f16x8*>(a);
        f16x8 b1 = *reinterpret_cast<const f16x8*>(a + 32 * 256);
        p0 = __builtin_amdgcn_mfma_f32_32x32x16_f16(b0, qr[d0], p0, 0, 0, 0);
        p1 = __builtin_amdgcn_mfma_f32_32x32x16_f16(b1, qr[d0], p1, 0, 0, 0); }
}
template <int VB>
__device__ __forceinline__ void pv_tile(f32x16* o, int vb0, f16x8 pa0, f16x8 pa1, f16x8 pa2, f16x8 pa3) {
    typedef _Float16 h4 __attribute__((ext_vector_type(4)));
#define TRRD(dst, off) asm volatile("ds_read_b64_tr_b16 %0, %1 offset:%2" : "=&v"(dst) : "v"(vb0), "i"(off) : "memory")
#define PV_D0(d0) do { h4 l0, l1, l2, l3, h0, h1, h2, h3; constexpr int b_ = v_rd_off(d0, 0, 0); \
        TRRD(l0, b_); TRRD(h0, b_ + 2048); TRRD(l1, b_ + 4096); TRRD(h1, b_ + 6144); TRRD(l2, b_ + 8192); TRRD(h2, b_ + 10240); TRRD(l3, b_ + 12288); TRRD(h3, b_ + 14336); \
        asm volatile("s_waitcnt lgkmcnt(0)" ::: "memory"); SBAR();   \
        o[d0] = __builtin_amdgcn_mfma_f32_32x32x16_f16(pa0, (f16x8){l0[0], l0[1], l0[2], l0[3], h0[0], h0[1], h0[2], h0[3]}, o[d0], 0, 0, 0);   \
        o[d0] = __builtin_amdgcn_mfma_f32_32x32x16_f16(pa1, (f16x8){l1[0], l1[1], l1[2], l1[3], h1[0], h1[1], h1[2], h1[3]}, o[d0], 0, 0, 0);   \
        o[d0] = __builtin_amdgcn_mfma_f32_32x32x16_f16(pa2, (f16x8){l2[0], l2[1], l2[2], l2[3], h2[0], h2[1], h2[2], h2[3]}, o[d0], 0, 0, 0);   \
        o[d0] = __builtin_amdgcn_mfma_f32_32x32x16_f16(pa3, (f16x8){l3[0], l3[1], l3[2], l3[3], h3[0], h3[1], h3[2], h3[3]}, o[d0], 0, 0, 0); } while (0)
    PV_D0(0); PV_D0(1); PV_D0(2); PV_D0(3);
#undef PV_D0
#undef TRRD
}
struct BlockRef { const f16* Q; const f16* K; const f16* V; f16* O; float* ML; const unsigned long long* M; int P0, j_lo, j_hi, pad; };
struct Seam { f16x8 qr[8]; f16x8 st_v0, st_v1, st_k0, st_k1; };
#define VMW() asm volatile("s_waitcnt vmcnt(0)" ::: "memory")
#define VMWN(n) asm volatile("s_waitcnt vmcnt(%0)" :: "i"(n) : "memory")
#define SLOAD_H(rK, rV, k0) do { const unsigned so_ = (unsigned)(k0) * (HD * 2);     \
                         S.st_v0 = bld8(rV, kvoff, so_); S.st_v1 = bld8(rV, kvoff + 32 * HD * 2, so_);              \
                         S.st_k0 = bld8(rK, kvoff, so_); S.st_k1 = bld8(rK, kvoff + 32 * HD * 2, so_); } while (0)
#define SWRITE_HK(bf) do { *(f16x8*)(K_lds + (bf) * SHM_K + kws) = S.st_k0; *(f16x8*)(K_lds + (bf) * SHM_K + kws + 32 * 256) = S.st_k1; } while (0)
#define SWRITE_HV(bf) do { *(f16x8*)(V_lds + (bf) * SHM_V + vst0) = S.st_v0; *(f16x8*)(V_lds + (bf) * SHM_V + vst1) = S.st_v1; } while (0)
#define SWRITE_HVO(off) do { *(f16x8*)(V_lds + (off) + vst0) = S.st_v0; *(f16x8*)(V_lds + (off) + vst1) = S.st_v1; } while (0)
#define SWRITE_H(bf) do { SWRITE_HV(bf); SWRITE_HK(bf); } while (0)
__device__ __forceinline__ void att_prime(const BlockRef& cur, char* lds, Seam& S, int tid_) {
    const int tid = tid_, wid = __builtin_amdgcn_readfirstlane(tid >> 6), lane = tid & 63, r32 = lane & 31, hi = lane >> 5;
    const int sr = tid >> 4, sc = (tid & 15) * 8, kws = KSWZ(sr, sc * 2); char* K_lds = lds + 2 * SHM_V;
    const unsigned kvoff = (unsigned)((sr * HD + sc) * 2), qoff = (unsigned)((r32 * HD + hi * 8) * 2);
    const int kb0 = cur.j_lo * KVBLK;
    { const __amdgpu_buffer_rsrc_t rQ = mkrsrc(cur.Q, QB * HD * 2);
  _Pragma("unroll") for (int d0 = 0; d0 < 8; ++d0) S.qr[d0] = bld8(rQ, qoff + d0 * 32, (unsigned)(wid * QBLK * HD * 2)); }
    { const __amdgpu_buffer_rsrc_t rK = mkrsrc(cur.K, L * HD * 2), rV = mkrsrc(cur.V, L * HD * 2);
      SLOAD_H(rK, rV, kb0); } VMW(); SWRITE_HK(0);
    __syncthreads();
}
__device__ __forceinline__ void att_block(const BlockRef& cur, const BlockRef& nxt, char* lds, Seam& S, int tid_) {
    const int tid = tid_, wid = __builtin_amdgcn_readfirstlane(tid >> 6), lane = tid & 63, r32 = lane & 31, hi = lane >> 5;
    const int j_lo = cur.j_lo, NT = cur.j_hi - cur.j_lo;
    const int kbn = nxt.j_lo * KVBLK;
    const int qlo = cur.P0 + wid * QBLK;
    char* V_lds = lds; char* K_lds = lds + 2 * SHM_V;
    float* ws = (float*)(lds + OFF_WS) + wid * 64; float* li_l = ws, * al_l = ws + 32;
    const float* dtab = (const float*)(lds + OFF_DT);
    float m_reg = -1e30f, l_reg = 0; f32x16 o[4] = {};
    const int sr = tid >> 4, sc = (tid & 15) * 8, vst0 = v_st(sr, sc), vst1 = v_st(32 + sr, sc), kws = KSWZ(sr, sc * 2);
    const unsigned kvoff = (unsigned)((sr * HD + sc) * 2), qoff = (unsigned)((r32 * HD + hi * 8) * 2);
    const int vb0 = (int)(uintptr_t)V_lds + v_rd_base(lane);
    const __amdgpu_buffer_rsrc_t Kh = mkrsrc(cur.K, L * HD * 2), Vh = mkrsrc(cur.V, L * HD * 2);
    const __amdgpu_buffer_rsrc_t rM = mkrsrc((const char*)cur.M + (size_t)qlo * 1024, 32 * 1024);
    const unsigned moff = (unsigned)r32 * 1024u;
#define MWLO(t) (__builtin_amdgcn_raw_buffer_load_b32(rM, moff, (unsigned)(j_lo + (t)) * 8u, 0) >> sh4)
#define MWHI(t) (__builtin_amdgcn_raw_buffer_load_b32(rM, moff + 4u, (unsigned)(j_lo + (t)) * 8u, 0) >> sh4)
    const int sh4 = 4 * hi;
#define RESC(a) do { if (__any((a) < 1.f)) { int ln_; asm volatile("v_mbcnt_lo_u32_b32 %0, -1, 0\n\tv_mbcnt_hi_u32_b32 %0, -1, %0" : "=v"(ln_));     \
                     if ((ln_ >> 5) == 0) al_l[ln_ & 31] = (a); asm volatile("s_waitcnt lgkmcnt(0)" ::: "memory");              \
                     const float* alh_ = al_l + 4 * (ln_ >> 5);                                                                       \
                     _Pragma("unroll") for (int d_ = 0; d_ < 4; ++d_) _Pragma("unroll") for (int r = 0; r < 16; ++r) o[d_][r] *= alh_[crow(r, 0)]; } } while (0)
#define KBASE(t) ((j_lo + (t)) * KVBLK)
#define BIAST(P0_, P1_, t) do { const int kb_ = KBASE(t); if (kb_ > qlo - 176 && kb_ <= qlo + QBLK - 1) { int ln_;     \
        asm volatile("v_mbcnt_lo_u32_b32 %0, -1, 0\n\tv_mbcnt_hi_u32_b32 %0, -1, %0" : "=v"(ln_)); bias_tile(P0_, P1_, qlo + (ln_ & 31) - 4 * (ln_ >> 5) - kb_, dtab); } } while (0)
    constexpr int NQL = 8;
#define SEAM_K0() do { VMWN(NQL); SWRITE_HK(0); SBAR(); } while (0)
    f32x16 pA0, pA1, pB0, pB1; float mnA, mnB, alA, alB; f16x8 pa0, pa1, pa2, pa3;
    unsigned mlA, mlB = 0u, mhA, mhB = 0u;
    SWRITE_HV(0); SBAR();
    mlA = MWLO(0);
    if (NT > 1) { SLOAD_H(Kh, Vh, KBASE(1)); }
    SBAR(); qkt<0>(pA0, pA1, K_lds, r32, hi, S.qr);
    BIAST(pA0, pA1, 0); partialSM(pA0, pA1, m_reg, mnA, alA, mlA); mhA = MWHI(0);
    if (NT > 1) { VMWN(1); SWRITE_H(1); }
    __syncthreads();
    int vr = 0, vm = SHM_V, vw = OFF_V2;
#define HALF_STEP(PX0, PX1, mnX, alX, mlX, mhX, PY0, PY1, alY, mhY, t, KB, SB) do {                                         \
        mlX = MWLO(t);                                                                                                        \
        SBAR(); qkt<KB>(PX0, PX1, K_lds, r32, hi, S.qr);                                                                      \
        finishSM(PY0, PY1, alY, l_reg, pa0, pa1, pa2, pa3, mhY); SBAR();                                                      \
        if ((t) + 1 < NT) { SLOAD_H(Kh, Vh, KBASE((t) + 1)); SBAR(); }                                                        \
        pv_tile<0>(o, vb0 + vr, pa0, pa1, pa2, pa3); BIAST(PX0, PX1, (t)); partialSM(PX0, PX1, m_reg, mnX, alX, mlX);         \
        mhX = MWHI(t);                                                                                                        \
        if ((t) + 1 < NT) { VMWN(1); SWRITE_HK(SB); SWRITE_HVO(vw); }               \
        RESC(alX); __syncthreads();                                                                                           \
        { const int t_ = vr; vr = vm; vm = vw; vw = t_; } } while (0)
    for (int t = 1; t + 1 < NT; t += 2) {
        HALF_STEP(pB0, pB1, mnB, alB, mlB, mhB, pA0, pA1, alA, mhA, t, 1, 0);
        HALF_STEP(pA0, pA1, mnA, alA, mlA, mhA, pB0, pB1, alB, mhB, t + 1, 0, 1);
    }
    const bool even = (NT & 1) == 0;
    if (even) { mlB = MWLO(NT - 1); mhB = MWHI(NT - 1); SBAR(); qkt<1>(pB0, pB1, K_lds, r32, hi, S.qr); SBAR(); }
    { const __amdgpu_buffer_rsrc_t rKn = mkrsrc(nxt.K, L * HD * 2), rVn = mkrsrc(nxt.V, L * HD * 2);
      SLOAD_H(rKn, rVn, kbn); } SBAR();
    { const __amdgpu_buffer_rsrc_t rQ = mkrsrc(nxt.Q, QB * HD * 2);
#pragma unroll
      for (int d0 = 0; d0 < 8; ++d0) S.qr[d0] = bld8(rQ, qoff + d0 * 32, (unsigned)(wid * QBLK * HD * 2)); }
    SBAR();
    finishSM(pA0, pA1, alA, l_reg, pa0, pa1, pa2, pa3, mhA); SBAR();
    pv_tile<0>(o, vb0 + vr, pa0, pa1, pa2, pa3);
    if (even) { BIAST(pB0, pB1, NT - 1); partialSM(pB0, pB1, m_reg, mnB, alB, mlB); __syncthreads(); RESC(alB);
        finishSM(pB0, pB1, alB, l_reg, pa0, pa1, pa2, pa3, mhB); SBAR(); pv_tile<0>(o, vb0 + vm, pa0, pa1, pa2, pa3); }
    SBAR(); SEAM_K0();
    int lane_e; asm volatile("v_mbcnt_lo_u32_b32 %0, -1, 0\n\tv_mbcnt_hi_u32_b32 %0, -1, %0" : "=v"(lane_e));
    const int r32e = lane_e & 31, hie = lane_e >> 5;
    if (hie == 0) li_l[r32e] = l_reg; asm volatile("s_waitcnt lgkmcnt(0)" ::: "memory");
    f16* Ow = cur.O + (size_t)(wid * QBLK) * HD + r32e;
#pragma unroll
    for (int r = 0; r < 16; ++r) { const int orow = crow(r, hie); const float lr = li_l[orow]; const float rl = lr > 0.f ? __builtin_amdgcn_rcpf(lr) : 0.f;
#pragma unroll
        for (int d0 = 0; d0 < 4; ++d0) { const float v = o[d0][r] * rl; const float vn = swz_xor<1>(v);
            if ((r32e & 1) == 0) *(unsigned*)(Ow + (size_t)orow * HD + d0 * 32) = pack2(v, vn); } }
    if (hie == 0) { float* mlp = cur.ML + (size_t)(wid * QBLK + r32e) * 2; mlp[0] = m_reg; mlp[1] = l_reg; }
    __syncthreads();
#undef RESC
#undef MWLO
#undef MWHI
#undef KBASE
#undef BIAST
#undef SEAM_K0
#undef HALF_STEP
}
#undef VMW
#undef VMWN
#undef SLOAD_H
#undef SWRITE_HK
#undef SWRITE_HV
#undef SWRITE_H
}

__device__ __forceinline__ int t5_bucket(int rel) {
    if (rel < 0) rel = 0;
    if (rel < 16) return rel;
    const float relf = (float)rel;
    int large = 16 + (int)(logf(relf / 16.0f) / 2.0794415416798357f * 16.0f);
    return large < 31 ? large : 31;
}
__device__ __forceinline__ void attn_phase(int blk, const f16* __restrict__ qkv, const unsigned long long* __restrict__ mask, const float* __restrict__ rel_bias, f16* __restrict__ Opart, float* __restrict__ ML, char* lds, int w0) {
    const int h = blk & 7, rem = blk >> 3, p = rem >> 1, half = rem & 1;
    __syncthreads();
    const int tid_ = phase_tid(w0);
    if (tid_ < 320) { const int rel = tid_ - 96; float v = 0.f;
        if (rel >= 0 && rel < 113) v = (rel_bias[t5_bucket(rel) * NH + h] - rel_bias[31 * NH + h]) * (1.0f / att::SCALE);
        ((float*)(lds + att::OFF_DT))[tid_] = v; }
    const float* Qh = (const float*)nullptr; (void)Qh;
    auto mk = [&](int x) { att::BlockRef r; const int nt2 = 2 * (x + 1);
        r.Q = qkv + ((size_t)h * L + (size_t)x * 256) * HD; r.K = qkv + (size_t)(8 + h) * L * HD; r.V = qkv + (size_t)(16 + h) * L * HD;
        r.O = Opart + (((size_t)half * NH + h) * L + (size_t)x * 256) * HD; r.ML = ML + (((size_t)half * NH + h) * L + (size_t)x * 256) * 2;
        r.M = mask; r.P0 = x * 256; r.j_lo = half * nt2; r.j_hi = (half + 1) * nt2; r.pad = 0; return r; };
    att::BlockRef cur = mk(p); const att::BlockRef last = mk(31 - p);
    att::Seam S;
    att::att_prime(cur, lds, S, tid_);
    for (int pass = 0; pass < 2; ++pass) {
        att::att_block(cur, last, lds, S, tid_);
        cur = last;
    }
}
#define PIN16(a, b) asm volatile("" : "+v"(a[(b)+0]), "+v"(a[(b)+1]), "+v"(a[(b)+2]), "+v"(a[(b)+3]), "+v"(a[(b)+4]), "+v"(a[(b)+5]), "+v"(a[(b)+6]), "+v"(a[(b)+7]), \
                                    "+v"(a[(b)+8]), "+v"(a[(b)+9]), "+v"(a[(b)+10]), "+v"(a[(b)+11]), "+v"(a[(b)+12]), "+v"(a[(b)+13]), "+v"(a[(b)+14]), "+v"(a[(b)+15]))
constexpr int LOC_AP = 1040;
constexpr int LOC_BP = 516;
constexpr int LOC_D16 = 0, LOC_X16 = 32 * LOC_AP, LOC_BUF = 2 * 32 * LOC_AP, LOC_LDS = LOC_BUF + 32 * LOC_BP * 4;
struct LocParams { const f16* pl; const f16* poolWt; const f16* rWt; const f16* iWt; const float* pool_scale; const float* g_pool; const float* conv_w; const float* conv_b;
                   const float* r_b; const float* i_b; const float* lam; float* hloc; float* Pp; float* Acar; float* Hcar; f16* mixed16; int m8, pad; };
template <int WIN> __device__ __forceinline__ void pool_d(const float (&u)[48], int t0, int c, LAS unsigned char* lds) {
#pragma unroll
    for (int t = 0; t < 32; ++t) { float s = 0.f;
#pragma unroll
        for (int j = 0; j < WIN; ++j) s += u[t + 15 - j];
        const int cnt = (t0 + t + 1) < WIN ? (t0 + t + 1) : WIN;
        *(LAS f16*)(lds + LOC_D16 + t * LOC_AP + c * 2) = (f16)(s / (float)cnt - u[t + 15]); }
}
__device__ __forceinline__ void loc_mm(LAS unsigned char* lds, int aoff, const f16* __restrict__ Wt, int g, int cb, int lane) {
    const int i = lane & 31, kh = lane >> 5;
    f32x16 d = {};
    const f16* wp = Wt + ((size_t)(g * 128 + cb * 32 + i) * 128 + kh * 8);
#pragma unroll
    for (int kk = 0; kk < 8; ++kk) {
        const f16x8 a = *(const LAS f16x8*)(lds + aoff + i * LOC_AP + (g * 128 + kk * 16 + kh * 8) * 2);
        const f16x8 b = *(const f16x8*)(wp + kk * 16);
        d = __builtin_amdgcn_mfma_f32_32x32x16_f16(a, b, d, 0, 0, 0);
    }
    LAS float* buf = (LAS float*)(lds + LOC_BUF);
#pragma unroll
    for (int r = 0; r < 16; ++r) buf[((r & 3) + 8 * (r >> 2) + 4 * kh) * LOC_BP + g * 128 + cb * 32 + i] = d[r];
}
__device__ __forceinline__ void local_phase(int chunk, const LocParams& p, LAS unsigned char* lds, int w0) {
    const int c = phase_tid(w0), lane = c & 63, wid = __builtin_amdgcn_readfirstlane(c >> 6), g = wid >> 1, t0 = chunk * 32;
    LAS float* buf = (LAS float*)(lds + LOC_BUF);
    __syncthreads();
    float xc[32];
    {
        float u[48], v[48];
#pragma unroll
        for (int j = 0; j < 48; ++j) { const int tt = t0 - 15 + j; u[j] = (float)p.pl[(size_t)(tt > 0 ? tt : 0) * 1536 + c]; }
#pragma unroll
        for (int j = 0; j < 48; ++j) { int tt = t0 - 3 + j; tt = tt > 0 ? tt : 0; tt = tt < L ? tt : L - 1; v[j] = j < 35 ? (float)p.pl[(size_t)tt * 1536 + 512 + c] : 0.f; }
        const float w0 = p.conv_w[c], w1 = p.conv_w[LW + c], w2 = p.conv_w[2 * LW + c], w3 = p.conv_w[3 * LW + c], cb = p.conv_b[c];
        PIN16(u, 0); PIN16(u, 16); PIN16(u, 32);
        PIN16(v, 0); PIN16(v, 16); PIN16(v, 32);
#pragma unroll
        for (int j = 0; j < 15; ++j) u[j] = (t0 - 15 + j) >= 0 ? u[j] : 0.f;
        if (g == 0) pool_d<2>(u, t0, c, lds); else if (g == 1) pool_d<4>(u, t0, c, lds); else if (g == 2) pool_d<8>(u, t0, c, lds); else pool_d<16>(u, t0, c, lds);
#pragma unroll
        for (int j = 0; j < 3; ++j) v[j] = (t0 - 3 + j) >= 0 ? v[j] : 0.f;
#pragma unroll
        for (int t = 0; t < 32; ++t) { xc[t] = cb + w0 * v[t] + w1 * v[t + 1] + w2 * v[t + 2] + w3 * v[t + 3];
            *(LAS f16*)(lds + LOC_X16 + t * LOC_AP + c * 2) = (f16)xc[t]; }
    }
    __syncthreads();
    loc_mm(lds, LOC_X16, p.rWt, g, (wid & 1) * 2, lane); loc_mm(lds, LOC_X16, p.rWt, g, (wid & 1) * 2 + 1, lane);
    __syncthreads();
    float la[32];
    { const float rb = p.r_b[c], sp = log1pf(expf(-p.lam[c]));
#pragma unroll
      for (int t = 0; t < 32; ++t) { const float r = __builtin_amdgcn_rcpf(1.0f + __expf(-(buf[t * LOC_BP + c] + rb))); la[t] = -8.0f * r * sp; } }
    __syncthreads();
    loc_mm(lds, LOC_X16, p.iWt, g, (wid & 1) * 2, lane); loc_mm(lds, LOC_X16, p.iWt, g, (wid & 1) * 2 + 1, lane);
    __syncthreads();
    { const float ib = p.i_b[c]; float h = 0.f, P = 1.f;
#pragma unroll
      for (int t = 0; t < 32; ++t) { const float ig = __builtin_amdgcn_rcpf(1.0f + __expf(-(buf[t * LOC_BP + c] + ib)));
          const float x2 = 2.0f * la[t], a = __expf(la[t]);
          const float om = (x2 > -0.25f) ? -x2 * (1.0f + x2 * (0.5f + x2 * (0.16666667f + x2 * (0.041666668f + x2 * 0.0083333338f)))) : 1.0f - a * a;
          const float b = __builtin_amdgcn_sqrtf(om) * (ig * xc[t]);
          h = a * h + b; P *= a;
          p.hloc[(size_t)(t0 + t) * LW + c] = h; p.Pp[(size_t)(t0 + t) * LW + c] = P; }
      p.Acar[(size_t)chunk * LW + c] = P; p.Hcar[(size_t)chunk * LW + c] = h; }
    __syncthreads();
    loc_mm(lds, LOC_D16, p.poolWt, g, (wid & 1) * 2, lane); loc_mm(lds, LOC_D16, p.poolWt, g, (wid & 1) * 2 + 1, lane);
    __syncthreads();
    { const int t = c >> 4, seg = c & 15; float y[32]; float ss = 0.f;
#pragma unroll
      for (int j2 = 0; j2 < 16; ++j2) { const int co = 2 * (16 * j2 + seg); typedef float f32x2l __attribute__((ext_vector_type(2))); const f32x2l v2 = *(const LAS f32x2l*)(buf + t * LOC_BP + co);
          y[2 * j2] = v2[0] * p.pool_scale[co]; y[2 * j2 + 1] = v2[1] * p.pool_scale[co + 1]; ss += y[2 * j2] * y[2 * j2] + y[2 * j2 + 1] * y[2 * j2 + 1]; }
      ss += swz_xor<1>(ss); ss += swz_xor<2>(ss); ss += swz_xor<4>(ss); ss += swz_xor<8>(ss);
      const float rs = rsqrtf(ss * (1.0f / PW) + EPS);
      if (p.m8) { unsigned char* mp8 = (unsigned char*)p.mixed16 + (size_t)(t0 + t) * D + AW;
#pragma unroll
          for (int j2 = 0; j2 < 16; ++j2) { const int co = 2 * (16 * j2 + seg);
              *(unsigned short*)(mp8 + co) = (unsigned short)__builtin_amdgcn_cvt_pk_fp8_f32(y[2 * j2] * rs * p.g_pool[co], y[2 * j2 + 1] * rs * p.g_pool[co + 1], 0u, false); } }
      else { f16* mp = p.mixed16 + (size_t)(t0 + t) * D + AW;
#pragma unroll
          for (int j2 = 0; j2 < 16; ++j2) { const int co = 2 * (16 * j2 + seg);
              *(unsigned*)(mp + co) = pack2(y[2 * j2] * rs * p.g_pool[co], y[2 * j2 + 1] * rs * p.g_pool[co + 1]); } } }
    __syncthreads();
}
__device__ __forceinline__ void carry_phase(int grp, const float* __restrict__ Acar, const float* __restrict__ Hcar, float* __restrict__ Apre, float* __restrict__ Hpre, float* __restrict__ AG, float* __restrict__ HG, int w0) {
    const int c = phase_tid(w0); float A = 1.f, H = 0.f;
#pragma unroll
    for (int k = 0; k < 16; ++k) { const size_t o = (size_t)(grp * 16 + k) * LW + c; Apre[o] = A; Hpre[o] = H; const float a = Acar[o], h = Hcar[o]; H = a * H + h; A = a * A; }
    AG[(size_t)grp * LW + c] = A; HG[(size_t)grp * LW + c] = H;
}
__device__ __forceinline__ float gelu_tanh_f(float x) { const float u = 0.7978845608028654f * (x + 0.044715f * x * x * x); const float e = __expf(2.0f * u); return 0.5f * x * (1.0f + (1.0f - 2.0f / (e + 1.0f))); }
struct MixParams { const f16* Opart; const float* ML; const float* hloc; const float* Pp; const float* Apre; const float* Hpre; const float* AG; const float* HG; const f16* pl;
                   const float* g_attn; const float* g_lru; f16* mixed16; int m8, pad; };
__device__ __forceinline__ void mix_phase(int blk, const MixParams& p, LAS unsigned char* lds, int w0) {
    const int tid = phase_tid(w0), lane = tid & 63, wv = blk * 8 + __builtin_amdgcn_readfirstlane(tid >> 6);
    LAS float* Gin = (LAS float*)lds;
    __syncthreads();
    { float av[15], hv[15];
#pragma unroll
      for (int v = 0; v < 15; ++v) { av[v] = p.AG[(size_t)v * LW + tid]; hv[v] = p.HG[(size_t)v * LW + tid]; }
      float hcur = 0.f; Gin[tid] = 0.f;
#pragma unroll
      for (int v = 0; v < 15; ++v) { hcur = av[v] * hcur + hv[v]; Gin[(v + 1) * LW + tid] = hcur; } }
    __syncthreads();
    constexpr float C2 = 1.4426950408889634f * 0.08838834764831845f;
    for (int t = wv; t < L; t += NBLK * 8) {
        const int h = lane >> 3, d0 = (lane & 7) * 16;
        const size_t r0 = ((size_t)0 * NH + h) * L + t, r1 = ((size_t)1 * NH + h) * L + t;
        const float m0 = p.ML[r0 * 2], l0 = p.ML[r0 * 2 + 1], m1 = p.ML[r1 * 2], l1 = p.ML[r1 * 2 + 1];
        const float m = fmaxf(m0, m1), a0 = l0 * exp2f((m0 - m) * C2), a1 = l1 * exp2f((m1 - m) * C2), inv = 1.0f / (a0 + a1), cw0 = a0 * inv, cw1 = a1 * inv;
        f32x4 o[4]; float ss = 0.f;
#pragma unroll
        for (int q = 0; q < 4; q += 2) { const f16x8 x0 = *(const f16x8*)(p.Opart + r0 * HD + d0 + q * 4), x1 = *(const f16x8*)(p.Opart + r1 * HD + d0 + q * 4);
#pragma unroll
            for (int j = 0; j < 4; ++j) { o[q][j] = (float)x0[j] * cw0 + (float)x1[j] * cw1; o[q + 1][j] = (float)x0[4 + j] * cw0 + (float)x1[4 + j] * cw1; }
            ss += o[q][0] * o[q][0] + o[q][1] * o[q][1] + o[q][2] * o[q][2] + o[q][3] * o[q][3] + o[q + 1][0] * o[q + 1][0] + o[q + 1][1] * o[q + 1][1] + o[q + 1][2] * o[q + 1][2] + o[q + 1][3] * o[q + 1][3]; }
        ss = wave_sum(ss);
        const float ra = rsqrtf(ss * (1.0f / AW) + EPS);
        f16* mr = p.mixed16 + (size_t)t * D;
#pragma unroll
        for (int q = 0; q < 4; q += 2) { const int col = h * HD + d0 + q * 4; const f32x4 g0 = *(const f32x4*)(p.g_attn + col), g1 = *(const f32x4*)(p.g_attn + col + 4);
            const f32x4 y0 = o[q] * ra * g0, y1 = o[q + 1] * ra * g1;
            if (p.m8) { unsigned w0_ = 0u, w1_ = 0u; w0_ = __builtin_amdgcn_cvt_pk_fp8_f32(y0[0], y0[1], w0_, false); w0_ = __builtin_amdgcn_cvt_pk_fp8_f32(y0[2], y0[3], w0_, true);
                w1_ = __builtin_amdgcn_cvt_pk_fp8_f32(y1[0], y1[1], w1_, false); w1_ = __builtin_amdgcn_cvt_pk_fp8_f32(y1[2], y1[3], w1_, true);
                *(u32x2*)((unsigned char*)p.mixed16 + (size_t)t * D + col) = (u32x2){w0_, w1_}; }
            else *(u32x4*)(mr + col) = (u32x4){pack2(y0[0], y0[1]), pack2(y0[2], y0[3]), pack2(y1[0], y1[1]), pack2(y1[2], y1[3])}; }
        const int c0 = lane * 8, chunk = t >> 5, grp = chunk >> 4;
        float hin[8];
        { const f32x4 g0_ = *(const LAS f32x4*)(Gin + grp * LW + c0), g1_ = *(const LAS f32x4*)(Gin + grp * LW + c0 + 4);
#pragma unroll
          for (int j = 0; j < 4; ++j) { hin[j] = g0_[j]; hin[4 + j] = g1_[j]; } }
        float lo[8]; float sl = 0.f;
        {
            const size_t oc = (size_t)chunk * LW + c0, ot = (size_t)t * LW + c0;
            const f32x4 ap0 = *(const f32x4*)(p.Apre + oc), ap1 = *(const f32x4*)(p.Apre + oc + 4), hp0 = *(const f32x4*)(p.Hpre + oc), hp1 = *(const f32x4*)(p.Hpre + oc + 4);
            const f32x4 hl0 = *(const f32x4*)(p.hloc + ot), hl1 = *(const f32x4*)(p.hloc + ot + 4), pp0 = *(const f32x4*)(p.Pp + ot), pp1 = *(const f32x4*)(p.Pp + ot + 4);
            const f16x8 gth = *(const f16x8*)(p.pl + (size_t)t * 1536 + 1024 + c0);
            const f32x4 gt0 = {(float)gth[0], (float)gth[1], (float)gth[2], (float)gth[3]}, gt1 = {(float)gth[4], (float)gth[5], (float)gth[6], (float)gth[7]};
#pragma unroll
            for (int j = 0; j < 4; ++j) {
                const float hc0 = ap0[j] * hin[j] + hp0[j], hc1 = ap1[j] * hin[4 + j] + hp1[j];
                lo[j] = (hl0[j] + pp0[j] * hc0) * gelu_tanh_f(gt0[j]); lo[4 + j] = (hl1[j] + pp1[j] * hc1) * gelu_tanh_f(gt1[j]);
                sl += lo[j] * lo[j] + lo[4 + j] * lo[4 + j]; }
        }
        sl = wave_sum(sl);
        const float rl = rsqrtf(sl * (1.0f / LW) + EPS);
        { const f32x4 g0 = *(const f32x4*)(p.g_lru + c0), g1 = *(const f32x4*)(p.g_lru + c0 + 4);
          if (p.m8) { unsigned w0_ = 0u, w1_ = 0u; w0_ = __builtin_amdgcn_cvt_pk_fp8_f32(lo[0] * rl * g0[0], lo[1] * rl * g0[1], w0_, false); w0_ = __builtin_amdgcn_cvt_pk_fp8_f32(lo[2] * rl * g0[2], lo[3] * rl * g0[3], w0_, true);
              w1_ = __builtin_amdgcn_cvt_pk_fp8_f32(lo[4] * rl * g1[0], lo[5] * rl * g1[1], w1_, false); w1_ = __builtin_amdgcn_cvt_pk_fp8_f32(lo[6] * rl * g1[2], lo[7] * rl * g1[3], w1_, true);
              *(u32x2*)((unsigned char*)p.mixed16 + (size_t)t * D + AW + PW + c0) = (u32x2){w0_, w1_}; }
          else           *(u32x4*)(mr + AW + PW + c0) = (u32x4){pack2(lo[0] * rl * g0[0], lo[1] * rl * g0[1]), pack2(lo[2] * rl * g0[2], lo[3] * rl * g0[3]),
                                                pack2(lo[4] * rl * g1[0], lo[5] * rl * g1[1]), pack2(lo[6] * rl * g1[2], lo[7] * rl * g1[3])}; }
    }
}
#define XB_TMO      128
#define XB_XCNT(j)  (256  + 64 * (j))
#define XB_XSUB(j)  (1280 + 64 * (j))
#define XB_XGEN(j)  (2304 + 64 * (j))
#define XB_TOP      3328
#define XB_TOPGEN   3392
#define XCD_BAR_WORDS 3456
#define XB_SPIN_CAP (1u << 18)

__device__ __forceinline__ unsigned xb_ld(unsigned* p)              { return __hip_atomic_load(p, __ATOMIC_RELAXED, __HIP_MEMORY_SCOPE_AGENT); }
__device__ __forceinline__ unsigned xb_add(unsigned* p, unsigned v) { return __hip_atomic_fetch_add(p, v, __ATOMIC_RELAXED, __HIP_MEMORY_SCOPE_AGENT); }
__device__ __forceinline__ unsigned xb_xcc_id() { return (unsigned)__builtin_amdgcn_s_getreg((3 << 11) | 20) & 0xFu; }
#define XB_SPIN(cond, bar) do { unsigned _sp = 0; while (cond) { __builtin_amdgcn_s_sleep(1); \
    if ((++_sp & 255u) == 0u) { if (xb_ld(&(bar)[XB_TMO])) break; if (_sp > XB_SPIN_CAP) { atomicAdd(&(bar)[XB_TMO], 1u); break; } } } } while (0)

struct XcdBarrier {
    unsigned* bar; unsigned x;
    volatile LAS unsigned* st;
};

__device__ __forceinline__ XcdBarrier xcd_barrier_post(unsigned* bar, volatile LAS unsigned* st, bool is_t0  ) {
    XcdBarrier b; b.bar = bar; b.x = xb_xcc_id(); b.st = st;
    if (is_t0) (void)xb_add(&bar[XB_XCNT(b.x)], 1u);
    return b;
}
__device__ __forceinline__ void xcd_barrier_complete(unsigned* bar, unsigned x, unsigned& nloc, unsigned& nx) {
    const unsigned G = gridDim.x * gridDim.y * gridDim.z;
    unsigned sum, cnt, mine, sp = 0u;
    for (;;) {
        sum = 0u; cnt = 0u; mine = 0u;
#pragma unroll
        for (unsigned j = 0; j < 16; ++j) { const unsigned c = xb_ld(&bar[XB_XCNT(j)]); sum += c; cnt += (c > 0u) ? 1u : 0u; mine = (j == x) ? c : mine; }
        if (sum == G) break;
        __builtin_amdgcn_s_sleep(1);
        if ((++sp & 255u) == 0u) { if (xb_ld(&bar[XB_TMO])) break; if (sp > XB_SPIN_CAP) { atomicAdd(&bar[XB_TMO], 1u); break; } }
    }
    nloc = mine > 0u ? mine : 1u; nx = cnt > 0u ? cnt : 1u;
}

__device__ __forceinline__ void xcd_barrier(const XcdBarrier& b, bool is_t0) {
    asm volatile("s_waitcnt vmcnt(0)" ::: "memory");
    __syncthreads();
    if (is_t0) {
        unsigned* bar = b.bar;
        __builtin_amdgcn_s_waitcnt(0);
        unsigned nloc = b.st[0], nx = b.st[1];
        if (nloc == 0u) { xcd_barrier_complete(bar, b.x, nloc, nx); b.st[0] = nloc; b.st[1] = nx; }
        const unsigned old = xb_add(&bar[XB_XSUB(b.x)], 1u);
        const unsigned gen = old / nloc;
        if (old + 1u == (gen + 1u) * nloc) {
            __builtin_amdgcn_fence(__ATOMIC_RELEASE, "agent");
            asm volatile("s_waitcnt vmcnt(0)" ::: "memory");
            const unsigned og = xb_add(&bar[XB_TOP], 1u);
            const unsigned tg = og / nx;
            if (og + 1u == (tg + 1u) * nx) xb_add(&bar[XB_TOPGEN], 1u);
            else XB_SPIN(xb_ld(&bar[XB_TOPGEN]) == tg, bar);
            __builtin_amdgcn_fence(__ATOMIC_ACQUIRE, "agent");
            xb_add(&bar[XB_XGEN(b.x)], 1u);
            asm volatile("s_waitcnt vmcnt(0)" ::: "memory");
        } else {
            XB_SPIN(xb_ld(&bar[XB_XGEN(b.x)]) == gen, bar);
            __builtin_amdgcn_fence(__ATOMIC_ACQUIRE, "agent");
            asm volatile("s_waitcnt vmcnt(0)" ::: "memory");
        }
    }
    __syncthreads();
}

constexpr int PROJ_N1 = 16 * 256;
constexpr int LDS_BAR_OFF = IDX_LDS;
constexpr int MEGA_LDS = LDS_BAR_OFF + 16;
static_assert(IDX_LDS >= LOC_LDS && IDX_LDS >= pg8::STAGE_BYTES && IDX_LDS >= att::LDS_BYTES && (IDX_LDS % 16) == 0, "LDS carve");
struct MegaParams { const float* x_in; const float* c_in; const float* positions; const float* rel_bias; const float* w_mod; const float* b_mod; const float* g_pre_mix; const float* g_post_mix; const float* g_pre_mlp; const float* g_post_mlp; const float* w_in; const float* pool_w; const float* pool_scale; const float* conv_w; const float* conv_b; const float* gate_r_w; const float* gate_r_b; const float* gate_i_w; const float* gate_i_b; const float* lru_lambda; const float* g_attn_out; const float* g_pool_out; const float* g_lru_out; const float* w_out; const float* w_up; const float* w_down; float* out; unsigned char* ws; };
constexpr size_t al256(size_t x) { return (x + 255) & ~(size_t)255; }
constexpr size_t WS_BAR = 0, WS_CNT = (size_t)XCD_BAR_WORDS * 4  , WS_ZERO_BYTES = WS_CNT + (size_t)8 * 32 * 64 * 4,
    WS_SLOTS = al256(WS_ZERO_BYTES)  , WS_MOD = al256(WS_SLOTS + (size_t)8 * 32 * 256 * 8 * 4), WS_WIN = al256(WS_MOD + (size_t)DEPTH * 6 * D * 4), WS_WOUT = al256(WS_WIN + (size_t)DEPTH * INP * D * 2),
    WS_WUP = al256(WS_WOUT + (size_t)DEPTH * D * D * 2), WS_WDOWN = al256(WS_WUP + (size_t)DEPTH * MLPH * D * 2), WS_PWT = al256(WS_WDOWN + (size_t)DEPTH * D * MLPH * 2),
    WS_RWT = al256(WS_PWT + (size_t)DEPTH * 4 * 128 * 128 * 2), WS_IWT = al256(WS_RWT + (size_t)DEPTH * 4 * 128 * 128 * 2), WS_REGA = al256(WS_IWT + (size_t)DEPTH * 4 * 128 * 128 * 2),
    WS_H16 = al256(WS_REGA + (size_t)L * L * 4), WS_QKV = al256(WS_H16 + (size_t)L * D * 2), WS_QI = al256(WS_QKV + (size_t)3 * L * AW * 2), WS_KI = al256(WS_QI + (size_t)L * 1024 * 2), WS_WI = al256(WS_KI + (size_t)L * 64 * 2),
    WS_PL = al256(WS_WI + (size_t)L * 16 * 4), WS_MASK = al256(WS_PL + (size_t)L * 1536 * 4), WS_XW = al256(WS_MASK + (size_t)L * 128 * 8), WS_ML = al256(WS_XW + (size_t)L * D * 4),
    WS_HLOC = al256(WS_ML + (size_t)2 * NH * L * 2 * 4), WS_PP = al256(WS_HLOC + (size_t)L * LW * 4), WS_ACAR = al256(WS_PP + (size_t)L * LW * 4), WS_HCAR = al256(WS_ACAR + (size_t)256 * LW * 4),
    WS_APRE = al256(WS_HCAR + (size_t)256 * LW * 4), WS_HPRE = al256(WS_APRE + (size_t)256 * LW * 4), WS_AG = al256(WS_HPRE + (size_t)256 * LW * 4), WS_HG = al256(WS_AG + (size_t)16 * LW * 4),
    WS_END = al256(WS_HG + (size_t)16 * LW * 4);
constexpr size_t WS_S = WS_REGA, WS_U16 = WS_REGA, WS_Y = WS_REGA + (size_t)L * MLPH * 2, WS_OPART = WS_REGA + (size_t)L * MLPH * 3;
#define GBAR() do { PHASE_ENTER(); (void)blk; XcdBarrier bar_; bar_.bar = WSP(unsigned, WS_BAR); bar_.x = xb_xcc_id(); bar_.st = (volatile LAS unsigned*)(lds + LDS_BAR_OFF); \
    xcd_barrier(bar_, phase_tid(w0) == 0); } while (0)
__global__ __launch_bounds__(512, 2) void k_mega(MegaParams P) {
    (void)P;
    extern __shared__ __attribute__((aligned(16))) unsigned char shm[];
    LAS unsigned char* lds = (LAS unsigned char*)shm;
#define PHASE_ENTER() unsigned zoff_ = 0u; int blk = (int)blockIdx.x; asm volatile("" : "+s"(zoff_), "+s"(blk)); \
    const MegaParams* const PP = (const MegaParams*)((const __attribute__((address_space(4))) char*)__builtin_amdgcn_kernarg_segment_ptr() + zoff_);     \
    unsigned char* const ws = PP->ws + zoff_
#define WSP(T, off) ((T*)(ws + (off)))
    const int w0 = __builtin_amdgcn_readfirstlane((int)threadIdx.x >> 6);
    { const int t0 = phase_tid(w0); if (t0 < 4) ((LAS unsigned*)(lds + LDS_BAR_OFF))[t0] = 0u; }
    __syncthreads();
    { PHASE_ENTER(); (void)blk; (void)xcd_barrier_post(WSP(unsigned, WS_BAR), (volatile LAS unsigned*)(lds + LDS_BAR_OFF), phase_tid(w0) == 0); }
    { PHASE_ENTER();
      ProParams pp; pp.c = PP->c_in; pp.w_mod = PP->w_mod; pp.b_mod = PP->b_mod; pp.mod = WSP(float, WS_MOD); pp.w_in = PP->w_in; pp.w_out = PP->w_out; pp.w_up = PP->w_up; pp.w_down = PP->w_down;
      pp.wt_in = WSP(f16, WS_WIN); pp.wt_out = WSP(f16, WS_WOUT); pp.wt_up = WSP(f16, WS_WUP); pp.wt_down = WSP(f16, WS_WDOWN); pp.pool_w = PP->pool_w; pp.r_w = PP->gate_r_w; pp.i_w = PP->gate_i_w;
      pp.poolWt = WSP(f16, WS_PWT); pp.rWt = WSP(f16, WS_RWT); pp.iWt = WSP(f16, WS_IWT);
      prologue_phase(blk, pp, (LAS float*)lds, w0); }
    GBAR();
    { PHASE_ENTER(); norm_pre_phase(blk, PP->x_in, PP->g_pre_mix, WSP(float, WS_MOD) + D, WSP(float, WS_MOD), WSP(f16, WS_H16), w0); }
    GBAR();
    { constexpr int l = 0;
        { PHASE_ENTER();
          pg8::Gemm g; g.A = WSP(f16, WS_H16); g.Bt = WSP(f16, WS_WIN) + (size_t)l * INP * D; g.M = L; g.N = PROJ_N1; g.K = D; g.wexp = 127;
          pg8::EpiProj e; e.qkv = WSP(f16, WS_QKV); e.qi = WSP(f16, WS_QI); e.ki = WSP(f16, WS_KI); e.wi = WSP(float, WS_WI); e.pl = WSP(f16, WS_PL); e.pn0 = 0; e.pad = 0;
          pg8::StaticOrder S; S.init(g.M, g.N, NBLK, blk);
          pg8::gemm_phase<pg8::EpiProj, pg8::StaticOrder>(lds, g, S, e, w0); }
        GBAR();
        { PHASE_ENTER();
          pg8::Gemm g; g.A = WSP(f16, WS_H16); g.Bt = WSP(f16, WS_WIN) + (size_t)l * INP * D + (size_t)PROJ_N1 * D; g.M = L; g.N = INP - PROJ_N1; g.K = D; g.wexp = 127;
          pg8::EpiProj e; e.qkv = WSP(f16, WS_QKV); e.qi = WSP(f16, WS_QI); e.ki = WSP(f16, WS_KI); e.wi = WSP(float, WS_WI); e.pl = WSP(f16, WS_PL); e.pn0 = PROJ_N1 / 256; e.pad = 0;
          pg8::StaticOrder S; S.init(g.M, g.N, NBLK, blk);
          pg8::gemm_phase<pg8::EpiProj, pg8::StaticOrder>(lds, g, S, e, w0); }
        { PHASE_ENTER(); idx_phase(blk, WSP(f16, WS_QI), WSP(f16, WS_KI), WSP(float, WS_WI), WSP(float, WS_S), lds, w0); }
        { PHASE_ENTER();
          LocParams lp; lp.pl = WSP(f16, WS_PL); lp.poolWt = WSP(f16, WS_PWT) + (size_t)l * 4 * 128 * 128; lp.rWt = WSP(f16, WS_RWT) + (size_t)l * 4 * 128 * 128; lp.iWt = WSP(f16, WS_IWT) + (size_t)l * 4 * 128 * 128;
          lp.pool_scale = PP->pool_scale + (size_t)l * PW; lp.g_pool = PP->g_pool_out + (size_t)l * PW; lp.conv_w = PP->conv_w + (size_t)l * 4 * LW; lp.conv_b = PP->conv_b + (size_t)l * LW;
          lp.r_b = PP->gate_r_b + (size_t)l * LW; lp.i_b = PP->gate_i_b + (size_t)l * LW; lp.lam = PP->lru_lambda + (size_t)l * LW; lp.hloc = WSP(float, WS_HLOC); lp.Pp = WSP(float, WS_PP);
          lp.Acar = WSP(float, WS_ACAR); lp.Hcar = WSP(float, WS_HCAR); lp.mixed16 = WSP(f16, WS_H16); lp.m8 = 1; lp.pad = 0;
          local_phase(blk, lp, lds, w0); }
        GBAR();
        { PHASE_ENTER(); select_phase(blk, WSP(float, WS_S), WSP(unsigned long long, WS_MASK), lds, w0, WSP(f16, WS_QKV) + (size_t)16 * L * 128);
          if (blk < 16) carry_phase(blk, WSP(float, WS_ACAR), WSP(float, WS_HCAR), WSP(float, WS_APRE), WSP(float, WS_HPRE), WSP(float, WS_AG), WSP(float, WS_HG), w0); }
        GBAR();
        { PHASE_ENTER(); attn_phase(blk, WSP(f16, WS_QKV), WSP(unsigned long long, WS_MASK), PP->rel_bias, WSP(f16, WS_OPART), WSP(float, WS_ML), (char*)shm, w0); }
        GBAR();
        { PHASE_ENTER();
          MixParams mp; mp.Opart = WSP(f16, WS_OPART); mp.ML = WSP(float, WS_ML); mp.hloc = WSP(float, WS_HLOC); mp.Pp = WSP(float, WS_PP); mp.Apre = WSP(float, WS_APRE); mp.Hpre = WSP(float, WS_HPRE);
          mp.AG = WSP(float, WS_AG); mp.HG = WSP(float, WS_HG); mp.pl = WSP(f16, WS_PL);
          mp.g_attn = PP->g_attn_out + (size_t)l * AW; mp.g_lru = PP->g_lru_out + (size_t)l * LW; mp.mixed16 = WSP(f16, WS_H16); mp.m8 = 1; mp.pad = 0;
          mix_phase(blk, mp, lds, w0); }
        GBAR();
        { PHASE_ENTER(); const float* m = WSP(float, WS_MOD) + (size_t)l * 6 * D;
          pg8::Gemm g; g.A = WSP(f16, WS_H16); g.Bt = WSP(f16, WS_WOUT) + (size_t)l * D * D; g.M = L; g.N = D; g.K = D; g.wexp = 127;
          pg8::EpiResNorm e; e.xi = l == 0 ? PP->x_in : WSP(float, WS_XW); e.xo = WSP(float, WS_XW); e.mod = m; e.o_gate = 2 * D; e.gpost = PP->g_post_mix + (size_t)l * D;
          e.gpre = PP->g_pre_mlp + (size_t)l * D; e.o_scale = 4 * D; e.o_shift = 3 * D; e.h = WSP(f16, WS_H16);
          e.slots = WSP(float, WS_SLOTS); e.cnt = WSP(unsigned, WS_CNT); e.use = l * 4 + 0; e.h8 = 1; e.x16 = (l == 0 ? 0 : 1) | 2;
          pg8::StaticOrder S; S.init(g.M, g.N, NBLK, blk);
          g.wexp = 121; pg8::gemm_phase<pg8::EpiResNorm, pg8::StaticOrder, true, true, true>(lds, g, S, e, w0); }
        GBAR();
        { PHASE_ENTER();
          pg8::Gemm g; g.A = WSP(f16, WS_H16); g.Bt = WSP(f16, WS_WUP) + (size_t)l * MLPH * D; g.M = L; g.N = MLPH; g.K = D; g.wexp = 127;
          pg8::StaticOrder S; S.init(g.M, g.N, NBLK, blk);
          { g.wexp = 121;
              pg8::EpiRelu2F8 e; e.O = WSP(unsigned char, WS_U16); e.ldc = MLPH; e.pad = 0; pg8::gemm_phase<pg8::EpiRelu2F8, pg8::StaticOrder, true, true, true>(lds, g, S, e, w0); } }
        GBAR();
        { PHASE_ENTER(); const float* m = WSP(float, WS_MOD) + (size_t)l * 6 * D;
          pg8::Gemm g; g.A = WSP(f16, WS_U16); g.Bt = WSP(f16, WS_WDOWN) + (size_t)l * D * MLPH; g.M = L; g.N = D; g.K = MLPH; g.wexp = 127;
          pg8::EpiResNorm e; e.xi = WSP(float, WS_XW); e.xo = (l == DEPTH - 1) ? PP->out : WSP(float, WS_XW); e.mod = m; e.o_gate = 5 * D; e.gpost = PP->g_post_mlp + (size_t)l * D;
          e.gpre = (l == DEPTH - 1) ? nullptr : PP->g_pre_mix + (size_t)(l + 1) * D; e.o_scale = 7 * D; e.o_shift = 6 * D; e.h = (l == DEPTH - 1) ? nullptr : WSP(f16, WS_H16);
          e.slots = WSP(float, WS_SLOTS); e.cnt = WSP(unsigned, WS_CNT); e.use = l * 4 + 2; e.h8 = 0; e.x16 = 1 | ((l == DEPTH - 1) ? 0 : 2);
          pg8::StaticOrder S; S.init(g.M, g.N, NBLK, blk);
          g.wexp = 120; pg8::gemm_phase<pg8::EpiResNorm, pg8::StaticOrder, true, true, true>(lds, g, S, e, w0); }
        if (l != DEPTH - 1) GBAR();
    }
    { constexpr int l = 1;
        { PHASE_ENTER();
          pg8::Gemm g; g.A = WSP(f16, WS_H16); g.Bt = WSP(f16, WS_WIN) + (size_t)l * INP * D; g.M = L; g.N = PROJ_N1; g.K = D; g.wexp = 127;
          pg8::EpiProj e; e.qkv = WSP(f16, WS_QKV); e.qi = WSP(f16, WS_QI); e.ki = WSP(f16, WS_KI); e.wi = WSP(float, WS_WI); e.pl = WSP(f16, WS_PL); e.pn0 = 0; e.pad = 0;
          pg8::StaticOrder S; S.init(g.M, g.N, NBLK, blk);
          pg8::gemm_phase<pg8::EpiProj, pg8::StaticOrder>(lds, g, S, e, w0); }
        GBAR();
        { PHASE_ENTER();
          pg8::Gemm g; g.A = WSP(f16, WS_H16); g.Bt = WSP(f16, WS_WIN) + (size_t)l * INP * D + (size_t)PROJ_N1 * D; g.M = L; g.N = INP - PROJ_N1; g.K = D; g.wexp = 127;
          pg8::EpiProj e; e.qkv = WSP(f16, WS_QKV); e.qi = WSP(f16, WS_QI); e.ki = WSP(f16, WS_KI); e.wi = WSP(float, WS_WI); e.pl = WSP(f16, WS_PL); e.pn0 = PROJ_N1 / 256; e.pad = 0;
          pg8::StaticOrder S; S.init(g.M, g.N, NBLK, blk);
          pg8::gemm_phase<pg8::EpiProj, pg8::StaticOrder>(lds, g, S, e, w0); }
        { PHASE_ENTER(); idx_phase(blk, WSP(f16, WS_QI), WSP(f16, WS_KI), WSP(float, WS_WI), WSP(float, WS_S), lds, w0); }
        { PHASE_ENTER();
          LocParams lp; lp.pl = WSP(f16, WS_PL); lp.poolWt = WSP(f16, WS_PWT) + (size_t)l * 4 * 128 * 128; lp.rWt = WSP(f16, WS_RWT) + (size_t)l * 4 * 128 * 128; lp.iWt = WSP(f16, WS_IWT) + (size_t)l * 4 * 128 * 128;
          lp.pool_scale = PP->pool_scale + (size_t)l * PW; lp.g_pool = PP->g_pool_out + (size_t)l * PW; lp.conv_w = PP->conv_w + (size_t)l * 4 * LW; lp.conv_b = PP->conv_b + (size_t)l * LW;
          lp.r_b = PP->gate_r_b + (size_t)l * LW; lp.i_b = PP->gate_i_b + (size_t)l * LW; lp.lam = PP->lru_lambda + (size_t)l * LW; lp.hloc = WSP(float, WS_HLOC); lp.Pp = WSP(float, WS_PP);
          lp.Acar = WSP(float, WS_ACAR); lp.Hcar = WSP(float, WS_HCAR); lp.mixed16 = WSP(f16, WS_H16); lp.m8 = 1; lp.pad = 0;
          local_phase(blk, lp, lds, w0); }
        GBAR();
        { PHASE_ENTER(); select_phase(blk, WSP(float, WS_S), WSP(unsigned long long, WS_MASK), lds, w0, WSP(f16, WS_QKV) + (size_t)16 * L * 128);
          if (blk < 16) carry_phase(blk, WSP(float, WS_ACAR), WSP(float, WS_HCAR), WSP(float, WS_APRE), WSP(float, WS_HPRE), WSP(float, WS_AG), WSP(float, WS_HG), w0); }
        GBAR();
        { PHASE_ENTER(); attn_phase(blk, WSP(f16, WS_QKV), WSP(unsigned long long, WS_MASK), PP->rel_bias, WSP(f16, WS_OPART), WSP(float, WS_ML), (char*)shm, w0); }
        GBAR();
        { PHASE_ENTER();
          MixParams mp; mp.Opart = WSP(f16, WS_OPART); mp.ML = WSP(float, WS_ML); mp.hloc = WSP(float, WS_HLOC); mp.Pp = WSP(float, WS_PP); mp.Apre = WSP(float, WS_APRE); mp.Hpre = WSP(float, WS_HPRE);
          mp.AG = WSP(float, WS_AG); mp.HG = WSP(float, WS_HG); mp.pl = WSP(f16, WS_PL);
          mp.g_attn = PP->g_attn_out + (size_t)l * AW; mp.g_lru = PP->g_lru_out + (size_t)l * LW; mp.mixed16 = WSP(f16, WS_H16); mp.m8 = 1; mp.pad = 0;
          mix_phase(blk, mp, lds, w0); }
        GBAR();
        { PHASE_ENTER(); const float* m = WSP(float, WS_MOD) + (size_t)l * 6 * D;
          pg8::Gemm g; g.A = WSP(f16, WS_H16); g.Bt = WSP(f16, WS_WOUT) + (size_t)l * D * D; g.M = L; g.N = D; g.K = D; g.wexp = 127;
          pg8::EpiResNorm e; e.xi = l == 0 ? PP->x_in : WSP(float, WS_XW); e.xo = WSP(float, WS_XW); e.mod = m; e.o_gate = 2 * D; e.gpost = PP->g_post_mix + (size_t)l * D;
          e.gpre = PP->g_pre_mlp + (size_t)l * D; e.o_scale = 4 * D; e.o_shift = 3 * D; e.h = WSP(f16, WS_H16);
          e.slots = WSP(float, WS_SLOTS); e.cnt = WSP(unsigned, WS_CNT); e.use = l * 4 + 0; e.h8 = 1; e.x16 = (l == 0 ? 0 : 1) | 2;
          pg8::StaticOrder S; S.init(g.M, g.N, NBLK, blk);
          g.wexp = 121; pg8::gemm_phase<pg8::EpiResNorm, pg8::StaticOrder, true, true, true>(lds, g, S, e, w0); }
        GBAR();
        { PHASE_ENTER();
          pg8::Gemm g; g.A = WSP(f16, WS_H16); g.Bt = WSP(f16, WS_WUP) + (size_t)l * MLPH * D; g.M = L; g.N = MLPH; g.K = D; g.wexp = 127;
          pg8::StaticOrder S; S.init(g.M, g.N, NBLK, blk);
          { g.wexp = 121;
              pg8::EpiRelu2F8 e; e.O = WSP(unsigned char, WS_U16); e.ldc = MLPH; e.pad = 0; pg8::gemm_phase<pg8::EpiRelu2F8, pg8::StaticOrder, true, true, true>(lds, g, S, e, w0); } }
        GBAR();
        { PHASE_ENTER(); const float* m = WSP(float, WS_MOD) + (size_t)l * 6 * D;
          pg8::Gemm g; g.A = WSP(f16, WS_U16); g.Bt = WSP(f16, WS_WDOWN) + (size_t)l * D * MLPH; g.M = L; g.N = D; g.K = MLPH; g.wexp = 127;
          pg8::EpiResNorm e; e.xi = WSP(float, WS_XW); e.xo = (l == DEPTH - 1) ? PP->out : WSP(float, WS_XW); e.mod = m; e.o_gate = 5 * D; e.gpost = PP->g_post_mlp + (size_t)l * D;
          e.gpre = (l == DEPTH - 1) ? nullptr : PP->g_pre_mix + (size_t)(l + 1) * D; e.o_scale = 7 * D; e.o_shift = 6 * D; e.h = (l == DEPTH - 1) ? nullptr : WSP(f16, WS_H16);
          e.slots = WSP(float, WS_SLOTS); e.cnt = WSP(unsigned, WS_CNT); e.use = l * 4 + 2; e.h8 = 0; e.x16 = 1 | ((l == DEPTH - 1) ? 0 : 2);
          pg8::StaticOrder S; S.init(g.M, g.N, NBLK, blk);
          g.wexp = 120; pg8::gemm_phase<pg8::EpiResNorm, pg8::StaticOrder, true, true, true>(lds, g, S, e, w0); }
        if (l != DEPTH - 1) GBAR();
    }
}
}

extern "C" void kernel_launch(void* const* d_in, const int* in_sizes, int n_in, void* d_out, int out_size, void* d_ws, size_t ws_size, hipStream_t stream) {
    (void)in_sizes; (void)out_size;
    if (n_in != 26 || ws_size < WS_END) return;
    MegaParams P{};
    P.x_in = (const float*)d_in[0]; P.c_in = (const float*)d_in[1]; P.positions = (const float*)d_in[2]; P.rel_bias = (const float*)d_in[3]; P.w_mod = (const float*)d_in[4]; P.b_mod = (const float*)d_in[5]; P.g_pre_mix = (const float*)d_in[6]; P.g_post_mix = (const float*)d_in[7]; P.g_pre_mlp = (const float*)d_in[8]; P.g_post_mlp = (const float*)d_in[9]; P.w_in = (const float*)d_in[10]; P.pool_w = (const float*)d_in[11]; P.pool_scale = (const float*)d_in[12]; P.conv_w = (const float*)d_in[13]; P.conv_b = (const float*)d_in[14]; P.gate_r_w = (const float*)d_in[15]; P.gate_r_b = (const float*)d_in[16]; P.gate_i_w = (const float*)d_in[17]; P.gate_i_b = (const float*)d_in[18]; P.lru_lambda = (const float*)d_in[19]; P.g_attn_out = (const float*)d_in[20]; P.g_pool_out = (const float*)d_in[21]; P.g_lru_out = (const float*)d_in[22]; P.w_out = (const float*)d_in[23]; P.w_up = (const float*)d_in[24]; P.w_down = (const float*)d_in[25];
    P.out = (float*)d_out; P.ws = (unsigned char*)d_ws;
    static bool attr_done = false;
    if (!attr_done) { attr_done = true; (void)hipFuncSetAttribute((const void*)k_mega, hipFuncAttributeMaxDynamicSharedMemorySize, MEGA_LDS); }
    (void)hipMemsetAsync((unsigned char*)d_ws + WS_BAR, 0, WS_ZERO_BYTES, stream);
    hipLaunchKernelGGL(k_mega, dim3(NBLK), dim3(NTHR), MEGA_LDS, stream, P);
}
```
